# Optimizing an MI355X kernel written in HIP

```python
import math
import jax, jax.numpy as jnp
from jax import lax
import numpy as np

D_MODEL = 1024
BATCH = 8
SEQ = 4096
DEPTH = 4

D_MIX = D_MODEL
N_ATTN_HEADS = 8
HEAD_DIM = 64
D_ATTN = N_ATTN_HEADS * HEAD_DIM
D_REC = D_MIX - D_ATTN
N_REC_BLOCKS = 8
REC_BLOCK = D_REC // N_REC_BLOCKS
CONV_WIDTH = 4
RG_C = 8.0
D_FF = 2816
Q_BLOCK = 128
EPS = 1e-6
D_IN = 3 * D_ATTN + N_ATTN_HEADS + 2 * D_REC
SPLITS = (D_ATTN, 2 * D_ATTN, 3 * D_ATTN, 3 * D_ATTN + N_ATTN_HEADS, 3 * D_ATTN + N_ATTN_HEADS + D_REC)

kernel_name = "fox_rglru_macaron_hybrid"


def rmsnorm(x, g):
    xf = x.astype(jnp.float32)
    y = xf * lax.rsqrt(jnp.mean(xf * xf, axis=-1, keepdims=True) + EPS)
    return (y * g.astype(jnp.float32)).astype(x.dtype)


def swiglu(h, w_in, w_out):
    gu = h @ w_in
    gate, up = jnp.split(gu, 2, axis=-1)
    return (jax.nn.silu(gate) * up) @ w_out


def forgetting_attention(q, k, v, log_f):
    b, s, h, dh = q.shape
    scale = 1.0 / math.sqrt(dh)
    c = jnp.cumsum(log_f, axis=1).transpose(0, 2, 1)
    qh, kh, vh = (t.transpose(0, 2, 1, 3) for t in (q, k, v))
    outs = []
    for start in range(0, s, Q_BLOCK):
        end = start + Q_BLOCK
        qb = qh[:, :, start:end]
        kb = kh[:, :, :end]
        vb = vh[:, :, :end]
        logits = jnp.einsum('bhqd,bhkd->bhqk', qb, kb).astype(jnp.float32) * scale
        logits = logits + (c[:, :, start:end, None] - c[:, :, None, :end])
        causal = (start + jnp.arange(Q_BLOCK))[:, None] >= jnp.arange(end)[None, :]
        logits = jnp.where(causal, logits, jnp.finfo(jnp.float32).min)
        p = jax.nn.softmax(logits, axis=-1)
        outs.append(jnp.einsum('bhqk,bhkd->bhqd', p.astype(vb.dtype), vb))
    o = jnp.concatenate(outs, axis=2)
    return o.transpose(0, 2, 1, 3)


def causal_depthwise_conv(x, w, bias):
    c = x.shape[-1]
    y = lax.conv_general_dilated(
        x, w[:, None, :].astype(x.dtype), window_strides=(1,), padding=[(CONV_WIDTH - 1, 0)],
        dimension_numbers=('NWC', 'WIO', 'NWC'), feature_group_count=c)
    return y + bias


def block_diag_linear(x, w, bias):
    b, s, c = x.shape
    xb = x.reshape(b, s, N_REC_BLOCKS, REC_BLOCK)
    y = jnp.einsum('bsnc,ncd->bsnd', xb, w).reshape(b, s, c)
    return y + bias


def rg_lru(x, w_a, b_a, w_x, b_x, lam):
    r = jax.nn.sigmoid(block_diag_linear(x, w_a, b_a).astype(jnp.float32))
    i = jax.nn.sigmoid(block_diag_linear(x, w_x, b_x).astype(jnp.float32))
    log_a = -RG_C * r * jax.nn.softplus(-lam.astype(jnp.float32))
    a = jnp.exp(log_a)
    mult = jnp.sqrt(-jnp.expm1(2.0 * log_a))
    u = mult * (i * x.astype(jnp.float32))

    def combine(left, right):
        a1, b1 = left
        a2, b2 = right
        return a1 * a2, a2 * b1 + b2

    _, h = lax.associative_scan(combine, (a, u), axis=1)
    return h.astype(x.dtype)


def hybrid_mixer(h, w_in, b_f, conv_w, conv_b, w_rg_a, b_rg_a, w_rg_x, b_rg_x, rg_lambda, w_out):
    b, s, _ = h.shape
    z = h @ w_in
    q, k, v, f_logit, xr, gr = jnp.split(z, SPLITS, axis=-1)
    q = q.reshape(b, s, N_ATTN_HEADS, HEAD_DIM)
    k = k.reshape(b, s, N_ATTN_HEADS, HEAD_DIM)
    v = v.reshape(b, s, N_ATTN_HEADS, HEAD_DIM)
    log_f = jax.nn.log_sigmoid((f_logit + b_f).astype(jnp.float32))
    y_attn = forgetting_attention(q, k, v, log_f).reshape(b, s, D_ATTN)
    xr = causal_depthwise_conv(xr, conv_w, conv_b)
    y_rec = rg_lru(xr, w_rg_a, b_rg_a, w_rg_x, b_rg_x, rg_lambda) * jax.nn.gelu(gr)
    return jnp.concatenate([y_attn, y_rec], axis=-1) @ w_out


def setup_inputs(seed: int = 0) -> dict:
    key = jax.random.key(seed)
    ks = jax.random.split(key, 16)
    f32 = jnp.float32
    x = jax.random.normal(ks[0], (BATCH, SEQ, D_MODEL), f32)
    norm_g = 1.0 + 0.02 * jax.random.normal(ks[1], (DEPTH, 3, D_MODEL), f32)
    w_in = jax.random.normal(ks[2], (DEPTH, D_MODEL, D_IN), f32) * D_MODEL ** -0.5
    b_f = 3.0 + 0.1 * jax.random.normal(ks[3], (DEPTH, N_ATTN_HEADS), f32)
    conv_w = jax.random.normal(ks[4], (DEPTH, CONV_WIDTH, D_REC), f32) * CONV_WIDTH ** -0.5
    conv_b = 0.01 * jax.random.normal(ks[5], (DEPTH, D_REC), f32)
    w_rg_a = jax.random.normal(ks[6], (DEPTH, N_REC_BLOCKS, REC_BLOCK, REC_BLOCK), f32) * REC_BLOCK ** -0.5
    b_rg_a = 0.01 * jax.random.normal(ks[7], (DEPTH, D_REC), f32)
    w_rg_x = jax.random.normal(ks[8], (DEPTH, N_REC_BLOCKS, REC_BLOCK, REC_BLOCK), f32) * REC_BLOCK ** -0.5
    b_rg_x = 0.01 * jax.random.normal(ks[9], (DEPTH, D_REC), f32)
    a_c = jax.random.uniform(ks[10], (DEPTH, D_REC), f32, 0.9, 0.999)
    s_base = a_c ** (1.0 / RG_C)
    rg_lambda = jnp.log(s_base) - jnp.log1p(-s_base)
    w_out = jax.random.normal(ks[11], (DEPTH, D_MIX, D_MODEL), f32) * D_MIX ** -0.5
    w_ffn_in = jax.random.normal(ks[12], (DEPTH, 2, D_MODEL, 2 * D_FF), f32) * D_MODEL ** -0.5
    w_ffn_out = jax.random.normal(ks[13], (DEPTH, 2, D_FF, D_MODEL), f32) * D_FF ** -0.5
    final_g = 1.0 + 0.02 * jax.random.normal(ks[14], (D_MODEL,), f32)
    return {"x": x, "norm_g": norm_g, "w_in": w_in, "b_f": b_f, "conv_w": conv_w, "conv_b": conv_b,
            "w_rg_a": w_rg_a, "b_rg_a": b_rg_a, "w_rg_x": w_rg_x, "b_rg_x": b_rg_x,
            "rg_lambda": rg_lambda, "w_out": w_out, "w_ffn_in": w_ffn_in, "w_ffn_out": w_ffn_out,
            "final_g": final_g}


def reference(x, norm_g, w_in, b_f, conv_w, conv_b, w_rg_a, b_rg_a, w_rg_x, b_rg_x,
              rg_lambda, w_out, w_ffn_in, w_ffn_out, final_g):
    for l in range(DEPTH):
        x = x + 0.5 * swiglu(rmsnorm(x, norm_g[l, 0]), w_ffn_in[l, 0], w_ffn_out[l, 0])
        x = x + hybrid_mixer(rmsnorm(x, norm_g[l, 1]), w_in[l], b_f[l], conv_w[l], conv_b[l],
                             w_rg_a[l], b_rg_a[l], w_rg_x[l], b_rg_x[l], rg_lambda[l], w_out[l])
        x = x + 0.5 * swiglu(rmsnorm(x, norm_g[l, 2]), w_ffn_in[l, 1], w_ffn_out[l, 1])
    return rmsnorm(x, final_g)
```

```cpp
#include <hip/hip_runtime.h>
#include <hip/hip_cooperative_groups.h>
#include <cstdio>
#include <cstdint>
namespace cg = cooperative_groups;
__device__ __forceinline__ int mk_tid() { int t = (int)threadIdx.x; asm volatile("" : "+v"(t)); return t; }
#ifndef MK_MULTI
#define MK_MULTI 0
#endif
namespace pg8 {
#define PG8_LAS __attribute__((address_space(3)))
typedef unsigned short bf16_t;
typedef short bf16x8 __attribute__((ext_vector_type(8)));
typedef float f32x4 __attribute__((ext_vector_type(4)));
typedef unsigned u32x4 __attribute__((ext_vector_type(4)));
constexpr int BM = 256, BK = 64, HALF = 128, HTB = HALF * BK * 2  , STAGE_BYTES = 8 * HTB, NXCD = 8, WGM = 8;

__host__ __device__ __forceinline__ int lds_byte(int r, int c) { const int st = (r >> 4) * 2 + (c >> 5), rr = r & 15, cc = c & 31, ob = rr * 64 + cc * 2; return st * 1024 + (ob ^ (((ob >> 9) & 1) << 5)); }
__host__ __device__ __forceinline__ void stage_rc(int b, int& R, int& C) { const int st = b / 1024, sb = b % 1024, swz = sb ^ (((sb >> 9) & 1) << 5); R = (st >> 1) * 16 + swz / 64; C = (st & 1) * 32 + (swz % 64) / 2; }
__host__ __device__ __forceinline__ int perm32(int rho) { const int n = rho >> 4, i = rho & 15; return 8 * (i >> 2) + 4 * n + (i & 3); }

struct Unit { int pm, pn; };
struct Gemm { const bf16_t* A; const bf16_t* Bt; int M, N, K; };

struct StaticOrder {
    int nM, nN, nwg, G, c, rev;
    __host__ __device__ void init(int M, int N, int G_, int c_, int rev_ = 0) { nM = M / BM; nN = N / BM; nwg = nM * nN; G = G_; c = c_; rev = rev_; }
    __host__ __device__ bool next(int i, Unit& u) const {
        const int nper = (nwg + G - 1) / G; if (i >= nper) return false;
        const long L = (long)(rev ? nper - 1 - i : i) * G + c; if (L >= nwg) return false;
        int wgid = (int)L; { const int q = nwg / NXCD, r = nwg % NXCD, xcd = wgid % NXCD, off = wgid / NXCD; wgid = (xcd < r ? xcd * (q + 1) : r * (q + 1) + (xcd - r) * q) + off; }
        const int nig = WGM * nN, gid = wgid / nig, fm = gid * WGM, gsz = (nM - fm) < WGM ? (nM - fm) : WGM;
        u.pm = fm + ((wgid % nig) % gsz); u.pn = (wgid % nig) / gsz; return true;
    }
    __device__ __forceinline__ void a_ready(const Unit&) const {}
    __device__ __forceinline__ void done(const Unit&) const {}
};

__device__ __forceinline__ unsigned cvt_pk_bf16(float lo, float hi) { unsigned r; asm volatile("v_cvt_pk_bf16_f32 %0, %1, %2" : "=v"(r) : "v"(lo), "v"(hi)); return r; }
typedef float f32x2 __attribute__((ext_vector_type(2)));
__device__ __forceinline__ float silu_mul(float g, float u) { return g * u * __builtin_amdgcn_rcpf(1.0f + __expf(-g)); }
__device__ __forceinline__ float row_rstd(const float* SSQ, int row) { const f32x4* p = (const f32x4*)(SSQ + (size_t)row * 16); const f32x4 a = p[0], b = p[1], c = p[2], d = p[3]; const f32x4 s = (a + b) + (c + d);
    return __builtin_amdgcn_rsqf(((s[0] + s[1]) + (s[2] + s[3])) * (1.0f / 1024.0f) + 1e-6f); }
__device__ __forceinline__ void rstd_panel(const float* SSQ, PG8_LAS float* RS, int pm, int wr, int wc, int fr, int fq) {
    const int t = (wr * 4 + wc) * 64 + fq * 16 + fr;
    if (t < BM) RS[t] = row_rstd(SSQ, pm * BM + t);
    asm volatile("s_waitcnt lgkmcnt(0)" ::: "memory"); __builtin_amdgcn_s_barrier(); asm volatile("" ::: "memory");
}
struct EpiSwiGLU {
    static constexpr bool PERM = true, AFTER_DRAIN = false;
    bf16_t* O; int ldc; const float* SSQ; PG8_LAS float* RS; mutable int cpm;
    __device__ __forceinline__ void operator()(const f32x4 (&acc)[2][2][4][2], const Unit& u, int wr, int wc, int fr, int fq) const {
        const int row0 = u.pm * BM + wr * 64 + fr, col0 = u.pn * HALF + wc * 32 + 8 * fq;
        if (u.pm != cpm) { rstd_panel(SSQ, RS, u.pm, wr, wc, fr, fq); cpm = u.pm; }
#pragma unroll
        for (int ai = 0; ai < 2; ++ai)
#pragma unroll
            for (int m = 0; m < 4; ++m) { bf16_t* rowp = O + (size_t)(row0 + ai * HALF + m * 16) * ldc + col0;
                const float rs = RS[ai * HALF + wr * 64 + m * 16 + fr]; const float c1 = rs * -1.4426950408889634f, rs2 = rs * rs;
                f32x4 o0, o1;
                { const f32x4 g = acc[ai][0][m][0], uu = acc[ai][1][m][0]; const f32x4 t = g * c1; f32x4 e; e[0] = __builtin_amdgcn_exp2f(t[0]); e[1] = __builtin_amdgcn_exp2f(t[1]); e[2] = __builtin_amdgcn_exp2f(t[2]); e[3] = __builtin_amdgcn_exp2f(t[3]);
                  const f32x4 d = e + 1.0f; f32x4 r; r[0] = __builtin_amdgcn_rcpf(d[0]); r[1] = __builtin_amdgcn_rcpf(d[1]); r[2] = __builtin_amdgcn_rcpf(d[2]); r[3] = __builtin_amdgcn_rcpf(d[3]); o0 = ((g * uu) * rs2) * r; }
                { const f32x4 g = acc[ai][0][m][1], uu = acc[ai][1][m][1]; const f32x4 t = g * c1; f32x4 e; e[0] = __builtin_amdgcn_exp2f(t[0]); e[1] = __builtin_amdgcn_exp2f(t[1]); e[2] = __builtin_amdgcn_exp2f(t[2]); e[3] = __builtin_amdgcn_exp2f(t[3]);
                  const f32x4 d = e + 1.0f; f32x4 r; r[0] = __builtin_amdgcn_rcpf(d[0]); r[1] = __builtin_amdgcn_rcpf(d[1]); r[2] = __builtin_amdgcn_rcpf(d[2]); r[3] = __builtin_amdgcn_rcpf(d[3]); o1 = ((g * uu) * rs2) * r; }
                u32x4 w; w.x = cvt_pk_bf16(o0[0], o0[1]); w.y = cvt_pk_bf16(o0[2], o0[3]); w.z = cvt_pk_bf16(o1[0], o1[1]); w.w = cvt_pk_bf16(o1[2], o1[3]);
                *(u32x4*)rowp = w; }
    }
};
struct EpiZ {
    static constexpr bool PERM = true, AFTER_DRAIN = false;
    bf16_t* O; int ldc; int nscale; float scale0; const float* SSQ; PG8_LAS float* RS; mutable int cpm;
    __device__ __forceinline__ void operator()(const f32x4 (&acc)[2][2][4][2], const Unit& u, int wr, int wc, int fr, int fq) const {
        const int row0 = u.pm * BM + wr * 64 + fr, col0 = u.pn * BM + wc * 32 + 8 * fq; const float sc = (u.pn < nscale) ? scale0 : 1.0f;
        if (u.pm != cpm) { rstd_panel(SSQ, RS, u.pm, wr, wc, fr, fq); cpm = u.pm; }
#pragma unroll
        for (int ai = 0; ai < 2; ++ai)
#pragma unroll
            for (int m = 0; m < 4; ++m) { bf16_t* rowp = O + (size_t)(row0 + ai * HALF + m * 16) * ldc + col0; const float rs = sc * RS[ai * HALF + wr * 64 + m * 16 + fr];
#pragma unroll
                for (int bj = 0; bj < 2; ++bj) { const f32x4 v0 = acc[ai][bj][m][0] * rs, v1 = acc[ai][bj][m][1] * rs;
                    u32x4 w; w.x = cvt_pk_bf16(v0[0], v0[1]); w.y = cvt_pk_bf16(v0[2], v0[3]); w.z = cvt_pk_bf16(v1[0], v1[1]); w.w = cvt_pk_bf16(v1[2], v1[3]);
                    *(u32x4*)(rowp + bj * HALF) = w; } }
    }
};
struct EpiRes {
    static constexpr bool PERM = false, AFTER_DRAIN = false;
    const float* base; float* out; int ldc; float alpha; bf16_t* XB; float* SSQ;
    __device__ __forceinline__ void operator()(const f32x4 (&acc)[2][2][4][2], const Unit& u, int wr, int wc, int fr, int fq) const {
        typedef unsigned u32x2v __attribute__((ext_vector_type(2)));
        const int col0 = u.pn * BM + wc * 32 + 4 * fq;
#pragma unroll
        for (int ai = 0; ai < 2; ++ai) {
            f32x4 pre[4][2][2];
#pragma unroll
            for (int m = 0; m < 4; ++m) { const size_t off = (size_t)(u.pm * BM + ai * HALF + wr * 64 + m * 16 + fr) * ldc + col0;
#pragma unroll
                for (int bj = 0; bj < 2; ++bj)
#pragma unroll
                    for (int n = 0; n < 2; ++n) pre[m][bj][n] = *(const f32x4*)(base + off + bj * HALF + n * 16); }
            asm volatile("" ::: "memory");
#pragma unroll
            for (int m = 0; m < 4; ++m) { const int row = u.pm * BM + ai * HALF + wr * 64 + m * 16 + fr; const size_t off = (size_t)row * ldc + col0; float ss = 0.f;
#pragma unroll
                for (int bj = 0; bj < 2; ++bj)
#pragma unroll
                    for (int n = 0; n < 2; ++n) { const f32x4 v = pre[m][bj][n] + acc[ai][bj][m][n] * alpha; *(f32x4*)(out + off + bj * HALF + n * 16) = v;
                        ss += (v[0] * v[0] + v[1] * v[1]) + (v[2] * v[2] + v[3] * v[3]); u32x2v w; w.x = cvt_pk_bf16(v[0], v[1]); w.y = cvt_pk_bf16(v[2], v[3]); *(u32x2v*)(XB + off + bj * HALF + n * 16) = w; }
                ss += __shfl_xor(ss, 16); ss += __shfl_xor(ss, 32); if (fq == 0) SSQ[(size_t)row * 16 + u.pn * 4 + wc] = ss; }
            asm volatile("" ::: "memory");
        }
    }
};
struct EpiResB {
    static constexpr bool PERM = true, AFTER_DRAIN = false;
    bf16_t* X; int ldc; float alpha; float* SSQ;
    __device__ __forceinline__ void operator()(const f32x4 (&acc)[2][2][4][2], const Unit& u, int wr, int wc, int fr, int fq) const {
        const int col0 = u.pn * BM + wc * 32 + 8 * fq;
#pragma unroll
        for (int ai = 0; ai < 2; ++ai) {
            u32x4 pre[4][2];
#pragma unroll
            for (int m = 0; m < 4; ++m) { const size_t off = (size_t)(u.pm * BM + ai * HALF + wr * 64 + m * 16 + fr) * ldc + col0;
#pragma unroll
                for (int bj = 0; bj < 2; ++bj) pre[m][bj] = *(const u32x4*)(X + off + bj * HALF); }
            asm volatile("" ::: "memory");
#pragma unroll
            for (int m = 0; m < 4; ++m) { const int row = u.pm * BM + ai * HALF + wr * 64 + m * 16 + fr; const size_t off = (size_t)row * ldc + col0; float ss = 0.f;
#pragma unroll
                for (int bj = 0; bj < 2; ++bj) { const u32x4 b = pre[m][bj]; const f32x4 a0 = acc[ai][bj][m][0] * alpha, a1 = acc[ai][bj][m][1] * alpha; u32x4 w;
                    w.x = cvt_pk_bf16(__uint_as_float(b.x << 16) + a0[0], __uint_as_float(b.x & 0xffff0000u) + a0[1]); w.y = cvt_pk_bf16(__uint_as_float(b.y << 16) + a0[2], __uint_as_float(b.y & 0xffff0000u) + a0[3]);
                    w.z = cvt_pk_bf16(__uint_as_float(b.z << 16) + a1[0], __uint_as_float(b.z & 0xffff0000u) + a1[1]); w.w = cvt_pk_bf16(__uint_as_float(b.w << 16) + a1[2], __uint_as_float(b.w & 0xffff0000u) + a1[3]);
                    *(u32x4*)(X + off + bj * HALF) = w;
#pragma unroll
                    for (int q = 0; q < 4; ++q) { const float lo = __uint_as_float(w[q] << 16), hi = __uint_as_float(w[q] & 0xffff0000u); ss += lo * lo + hi * hi; } }
                ss += __shfl_xor(ss, 16); ss += __shfl_xor(ss, 32); if (fq == 0) SSQ[(size_t)row * 16 + u.pn * 4 + wc] = ss; }
            asm volatile("" ::: "memory");
        }
    }
};
template <class Epi, class Sched, bool ALIGN_EPI = false, bool SP2 = false>
__device__ __forceinline__ void gemm_phase(PG8_LAS unsigned char* lds, const Gemm g, const Sched& S, const Epi& E) {
    const int tid = mk_tid(), wid = __builtin_amdgcn_readfirstlane(tid >> 6), lane = tid & 63, wr = wid >> 2, wc = wid & 3, fr = lane & 15, fq = lane >> 4;
    const int K = g.K, nt = K / BK;
    unsigned voffA[2], voffB[2];
#pragma unroll
    for (int i = 0; i < 2; ++i) { int R, C; stage_rc(tid * 16 + i * 8192, R, C); const int Rb = Epi::PERM ? ((R & ~31) + perm32(R & 31)) : R;
        voffA[i] = (unsigned)(R * K + C) * 2u; voffB[i] = (unsigned)(Rb * K + C) * 2u; }
    const size_t kstep = (size_t)(BK * 2);
    const size_t hstep = (size_t)HALF * K * 2;
    const size_t tstep = 2 * hstep;
    const unsigned ldsw = (unsigned)wid * 1024u;
    const int aoff = lds_byte(wr * 64 + fr, fq * 8), boff = lds_byte(wc * 32 + fr, fq * 8);
#define PG8_SA(b, h) (((b) * 2 + (h)) * HTB)
#define PG8_SB(b, h) ((4 + (b) * 2 + (h)) * HTB)
#define PG8_STAGE(bufoff, gbase, voff) do { _Pragma("unroll") for (int _i = 0; _i < 2; ++_i) \
        __builtin_amdgcn_global_load_lds((const unsigned*)((const char*)(gbase) + (voff)[_i]), (PG8_LAS unsigned*)(lds + (bufoff) + ldsw + _i * 8192), 16, 0, 0); } while (0)
#define PG8_LDA(dst, b, h) do { _Pragma("unroll") for (int m = 0; m < 4; ++m) _Pragma("unroll") for (int k = 0; k < 2; ++k) dst[m][k] = *(const PG8_LAS bf16x8*)(lds + PG8_SA(b, h) + aoff + m * 2048 + k * 1024); } while (0)
#define PG8_LDB(dst, b, h) do { _Pragma("unroll") for (int n = 0; n < 2; ++n) _Pragma("unroll") for (int k = 0; k < 2; ++k) dst[n][k] = *(const PG8_LAS bf16x8*)(lds + PG8_SB(b, h) + boff + n * 2048 + k * 1024); } while (0)
#define PG8_MMA(ai, bj, At, Bt) do { __builtin_amdgcn_s_setprio(1); _Pragma("unroll") for (int m = 0; m < 4; ++m) _Pragma("unroll") for (int n = 0; n < 2; ++n) _Pragma("unroll") for (int k = 0; k < 2; ++k) \
        acc[ai][bj][m][n] = __builtin_amdgcn_mfma_f32_16x16x32_bf16(Bt[n][k], At[m][k], acc[ai][bj][m][n], 0, 0, 0); __builtin_amdgcn_s_setprio(0); } while (0)
#define PG8_WAIT_V(n) asm volatile("s_waitcnt vmcnt(" #n ")" ::: "memory")
#define PG8_WAIT_L(n) asm volatile("s_waitcnt lgkmcnt(" #n ")" ::: "memory")
#define PG8_BAR __builtin_amdgcn_s_barrier()
#define PG8_SCHED __builtin_amdgcn_sched_barrier(0)
    Unit cur, nxt; int ui = 0;
    if (!S.next(0, cur)) return;
    f32x4 acc[2][2][4][2];
#pragma unroll
    for (int a = 0; a < 2; ++a)
#pragma unroll
        for (int b = 0; b < 2; ++b)
#pragma unroll
            for (int m = 0; m < 4; ++m)
#pragma unroll
                for (int n = 0; n < 2; ++n) acc[a][b][m][n] = (f32x4){0.f, 0.f, 0.f, 0.f};
    bf16x8 At[4][2], B0[2][2], B1[2][2];
    const char* cA = (const char*)g.A + (size_t)cur.pm * tstep; const char* cB = (const char*)g.Bt + (size_t)cur.pn * tstep;
    S.a_ready(cur);
    if constexpr (SP2) {
        PG8_STAGE(PG8_SB(0, 0), cB, voffB); PG8_STAGE(PG8_SB(0, 1), cB + hstep, voffB); PG8_STAGE(PG8_SA(0, 0), cA, voffA); PG8_STAGE(PG8_SA(0, 1), cA + hstep, voffA);
        if (wr == 1) PG8_BAR;
        PG8_WAIT_V(2); PG8_BAR;
        PG8_STAGE(PG8_SB(1, 0), cB + kstep, voffB); PG8_STAGE(PG8_SA(1, 0), cA + kstep, voffA); PG8_STAGE(PG8_SB(1, 1), cB + hstep + kstep, voffB);
        PG8_WAIT_V(6); PG8_BAR;
    } else {
        PG8_STAGE(PG8_SB(0, 0), cB, voffB); PG8_STAGE(PG8_SA(0, 0), cA, voffA); PG8_STAGE(PG8_SB(0, 1), cB + hstep, voffB); PG8_STAGE(PG8_SA(0, 1), cA + hstep, voffA);
        if (wr == 1) PG8_BAR;
        PG8_WAIT_V(4); PG8_BAR;
        PG8_STAGE(PG8_SB(1, 0), cB + kstep, voffB); PG8_STAGE(PG8_SA(1, 0), cA + kstep, voffA); PG8_STAGE(PG8_SB(1, 1), cB + hstep + kstep, voffB);
        PG8_WAIT_V(6); PG8_BAR;
    }
    for (;;) {
        const bool has_next = S.next(ui + 1, nxt);
        const char* nA = has_next ? (const char*)g.A + (size_t)nxt.pm * tstep : cA; const char* nB = has_next ? (const char*)g.Bt + (size_t)nxt.pn * tstep : cB;
        for (int t = 0; t < nt; t += 2) {
            const bool last = (t == nt - 2);
            const char* a1 = cA + (size_t)(t + 1) * kstep;
            const char* a2 = last ? nA : cA + (size_t)(t + 2) * kstep; const char* b2 = last ? nB : cB + (size_t)(t + 2) * kstep;
            const char* a3 = a2 + kstep; const char* b3 = b2 + kstep;
            if (last && has_next) S.a_ready(nxt);
            if constexpr (SP2) {
            PG8_LDB(B0, 0, 0); PG8_LDB(B1, 0, 1); PG8_SCHED; PG8_LDA(At, 0, 0); PG8_STAGE(PG8_SA(1, 1), a1 + hstep, voffA);
            PG8_WAIT_V(8); PG8_WAIT_L(0); PG8_BAR; PG8_MMA(0, 0, At, B0); PG8_MMA(0, 1, At, B1); PG8_BAR; PG8_SCHED;
            PG8_LDA(At, 0, 1); PG8_STAGE(PG8_SB(0, 0), b2, voffB); PG8_STAGE(PG8_SB(0, 1), b2 + hstep, voffB); PG8_STAGE(PG8_SA(0, 0), a2, voffA);
            PG8_WAIT_V(8); PG8_WAIT_L(0); PG8_BAR; PG8_MMA(1, 0, At, B0); PG8_MMA(1, 1, At, B1); PG8_BAR; PG8_SCHED;
            PG8_LDB(B0, 1, 0); PG8_LDB(B1, 1, 1); PG8_SCHED; PG8_LDA(At, 1, 0); PG8_STAGE(PG8_SA(0, 1), a2 + hstep, voffA);
            PG8_WAIT_V(8); PG8_WAIT_L(0); PG8_BAR; PG8_MMA(0, 0, At, B0); PG8_MMA(0, 1, At, B1); PG8_BAR; PG8_SCHED;
            PG8_LDA(At, 1, 1); PG8_STAGE(PG8_SB(1, 0), b3, voffB); PG8_STAGE(PG8_SB(1, 1), b3 + hstep, voffB); PG8_STAGE(PG8_SA(1, 0), a3, voffA);
            PG8_WAIT_V(8); PG8_WAIT_L(0); PG8_BAR; PG8_MMA(1, 0, At, B0); PG8_MMA(1, 1, At, B1); PG8_BAR; PG8_SCHED;
            } else {
            PG8_LDB(B0, 0, 0); PG8_SCHED; PG8_LDA(At, 0, 0); PG8_STAGE(PG8_SA(1, 1), a1 + hstep, voffA);
            PG8_WAIT_L(8); PG8_BAR; PG8_WAIT_L(0); PG8_MMA(0, 0, At, B0); PG8_BAR; PG8_SCHED;
            PG8_LDB(B1, 0, 1); PG8_STAGE(PG8_SB(0, 0), b2, voffB);
            PG8_BAR; PG8_WAIT_L(0); PG8_MMA(0, 1, At, B1); PG8_BAR;
            PG8_LDA(At, 0, 1); PG8_STAGE(PG8_SA(0, 0), a2, voffA);
            PG8_BAR; PG8_WAIT_L(0); PG8_MMA(1, 0, At, B0); PG8_BAR; PG8_SCHED;
            PG8_STAGE(PG8_SB(0, 1), b2 + hstep, voffB);
            PG8_WAIT_V(6); PG8_BAR; PG8_MMA(1, 1, At, B1); PG8_BAR;
            PG8_LDB(B0, 1, 0); PG8_SCHED; PG8_LDA(At, 1, 0); PG8_STAGE(PG8_SA(0, 1), a2 + hstep, voffA);
            PG8_WAIT_L(8); PG8_BAR; PG8_WAIT_L(0); PG8_MMA(0, 0, At, B0); PG8_BAR; PG8_SCHED;
            PG8_LDB(B1, 1, 1); PG8_STAGE(PG8_SB(1, 0), b3, voffB);
            PG8_BAR; PG8_WAIT_L(0); PG8_MMA(0, 1, At, B1); PG8_BAR;
            PG8_LDA(At, 1, 1); PG8_STAGE(PG8_SA(1, 0), a3, voffA);
            PG8_BAR; PG8_WAIT_L(0); PG8_MMA(1, 0, At, B0); PG8_BAR; PG8_SCHED;
            PG8_STAGE(PG8_SB(1, 1), b3 + hstep, voffB);
            PG8_WAIT_V(6); PG8_BAR; PG8_MMA(1, 1, At, B1); PG8_BAR;
            }
        }
        if constexpr (ALIGN_EPI) { if (wr == 0) PG8_BAR; }
        if constexpr (!Epi::AFTER_DRAIN) { E(acc, cur, wr, wc, fr, fq); S.done(cur); }
        if (!has_next) break;
#pragma unroll
        for (int a = 0; a < 2; ++a)
#pragma unroll
            for (int b = 0; b < 2; ++b)
#pragma unroll
                for (int m = 0; m < 4; ++m)
#pragma unroll
                    for (int n = 0; n < 2; ++n) acc[a][b][m][n] = (f32x4){0.f, 0.f, 0.f, 0.f};
        cur = nxt; cA = nA; cB = nB; ++ui;
        if constexpr (ALIGN_EPI) { if (wr == 1) PG8_BAR; }
    }
    PG8_WAIT_V(0);
    if constexpr (!ALIGN_EPI) { if (wr == 0) PG8_BAR; }
    PG8_BAR;
    if constexpr (Epi::AFTER_DRAIN) { E.fused(acc, cur, wr, wc, fr, fq, lds, wid, lane); S.done(cur); }
#undef PG8_SA
#undef PG8_SB
#undef PG8_STAGE
#undef PG8_LDA
#undef PG8_LDB
#undef PG8_MMA
#undef PG8_WAIT_V
#undef PG8_WAIT_L
#undef PG8_BAR
#undef PG8_SCHED
}
}

#ifndef PG8_SP2
#define PG8_SP2 true
#endif
#ifndef PG8_ALIGN
#define PG8_ALIGN true
#endif
#include <hip/hip_bf16.h>
#include <cmath>
namespace attn_body {
using bf16=__hip_bfloat16;
using bf16x8=__attribute__((ext_vector_type(8)))short;
using s16x4=__attribute__((ext_vector_type(4)))short;
using f32x16=__attribute__((ext_vector_type(16)))float;
using u32x4=__attribute__((ext_vector_type(4)))unsigned;
constexpr int BATCH=8,NHEAD=8,SEQ=4096,D=64,DM=2560,OP=1024;
constexpr int NW=8,QBLK=32,QB=QBLK*NW,KVBLK=64,NQB=SEQ/QB;
constexpr int ATTN_PITCH=DM, ATTN_UNIT_ROWS=QB;
__device__ __forceinline__ int crow(int r,int hi){return (r&3)+8*(r>>2)+4*hi;}
#define SBAR() __builtin_amdgcn_sched_barrier(0)
__device__ __forceinline__ void cmask(f32x16&p0,f32x16&p1,int jb,int qrel,int hi){
  const float NEG=-INFINITY; int kb=64*jb+4*hi;
  #pragma unroll
  for(int r=0;r<16;++r){int kv=kb+(r&3)+8*(r>>2); if(kv>qrel)p0[r]=NEG; if(kv+32>qrel)p1[r]=NEG;}
}

constexpr int NSLOT=3, SLOTB=8192;
constexpr int LDS_K=0, LDS_V=NSLOT*SLOTB, LDS_WS=2*NSLOT*SLOTB, LDS_OST=LDS_WS+NW*64*4, LDS_BYTES=LDS_OST+NW*4096, LDS_EXT=86016  , LDS_EXTZ=LDS_EXT+32768  , LDS_CBW=LDS_EXTZ+512;
constexpr float C2=0.125f*1.4426950408889634f;
__device__ __forceinline__ void glds16(const void*gsrc,unsigned lds_dst){unsigned keep;
  asm volatile("s_mov_b32 %0, m0\n\ts_mov_b32 m0, %2\n\ts_nop 0\n\tglobal_load_lds_dwordx4 %1, off\n\ts_mov_b32 m0, %0":"=&s"(keep):"v"(gsrc),"s"(lds_dst):"memory");}
__device__ __forceinline__ float max3f(float a,float b,float c){float r;asm("v_max3_f32 %0, %1, %2, %3":"=v"(r):"v"(a),"v"(b),"v"(c));return r;}
__device__ __forceinline__ float max2f(float a,float b){float r;asm("v_max_f32_e32 %0, %1, %2":"=v"(r):"v"(a),"v"(b));return r;}
__device__ __forceinline__ float fadd_s(float a,float b){float r;asm("v_add_f32_e32 %0, %1, %2":"=v"(r):"v"(a),"v"(b));return r;}
__device__ __forceinline__ float fsub_s(float a,float b){float r;asm("v_sub_f32_e32 %0, %1, %2":"=v"(r):"v"(a),"v"(b));return r;}
typedef float f32x2_t __attribute__((ext_vector_type(2))); typedef __bf16 bf16x2_t __attribute__((ext_vector_type(2)));
__device__ __forceinline__ unsigned cvtpk_s(float lo,float hi){f32x2_t v={lo,hi};bf16x2_t b=__builtin_convertvector(v,bf16x2_t);return __builtin_bit_cast(unsigned,b);}
#define WAIT_BAR(N) asm volatile("s_waitcnt vmcnt(" #N ") lgkmcnt(0)\n\ts_barrier":::"memory")

__device__ __forceinline__ void qkt(f32x16&p0,f32x16&p1,const char*Kslot,const bf16x8*qr,const f32x16&negm,int r32,int hi){
  const char*kb=Kslot+hi*1024+r32*16;
  #pragma unroll
  for(int d0=0;d0<4;++d0){
    const bf16x8 b0=*reinterpret_cast<const bf16x8*>(kb+d0*2048);
    const bf16x8 b1=*reinterpret_cast<const bf16x8*>(kb+d0*2048+512);
    {p0=__builtin_amdgcn_mfma_f32_32x32x16_bf16(b0,qr[d0],p0,0,0,0);p1=__builtin_amdgcn_mfma_f32_32x32x16_bf16(b1,qr[d0],p1,0,0,0);}}
}
typedef __attribute__((address_space(3))) const char* lds_cptr;
typedef short v4i16_t __attribute__((ext_vector_type(4)));
__device__ __forceinline__ void kload8(bf16x8*kf,lds_cptr kp){
  kf[0]=*(const __attribute__((address_space(3))) bf16x8*)(kp);      kf[1]=*(const __attribute__((address_space(3))) bf16x8*)(kp+512);
  kf[2]=*(const __attribute__((address_space(3))) bf16x8*)(kp+2048); kf[3]=*(const __attribute__((address_space(3))) bf16x8*)(kp+2560);
  kf[4]=*(const __attribute__((address_space(3))) bf16x8*)(kp+4096); kf[5]=*(const __attribute__((address_space(3))) bf16x8*)(kp+4608);
  kf[6]=*(const __attribute__((address_space(3))) bf16x8*)(kp+6144); kf[7]=*(const __attribute__((address_space(3))) bf16x8*)(kp+6656);
}
__device__ __forceinline__ void kload2(bf16x8*kf,lds_cptr kp,int j){ kf[2*j]=*(const __attribute__((address_space(3))) bf16x8*)(kp+j*2048); kf[2*j+1]=*(const __attribute__((address_space(3))) bf16x8*)(kp+j*2048+512); }
__device__ __forceinline__ s16x4 vtr(lds_cptr p){ return __builtin_bit_cast(s16x4,__builtin_amdgcn_ds_read_tr16_b64_v4i16((__attribute__((address_space(3))) v4i16_t*)p)); }
__device__ __forceinline__ float rowmax(const f32x16&p0,const f32x16&p1){
  float a=max3f(p0[0],p0[1],p1[0]),b=max3f(p0[2],p0[3],p1[1]);a=max3f(a,p1[2],p1[3]);
  #pragma unroll
  for(int r=4;r<16;r+=4){a=max3f(a,p0[r],p0[r+1]);b=max3f(b,p0[r+2],p0[r+3]);a=max3f(a,p1[r],p1[r+1]);b=max3f(b,p1[r+2],p1[r+3]);}
  const float m=max2f(a,b);
  auto rr=__builtin_amdgcn_permlane32_swap(__float_as_uint(m),__float_as_uint(m),false,false);
  return max2f(__uint_as_float(rr[0]),__uint_as_float(rr[1]));
}
__device__ __forceinline__ void pv(f32x16*o,int vb,bf16x8 pa0,bf16x8 pa1,bf16x8 pa2,bf16x8 pa3){
  #pragma unroll
  for(int d0=0;d0<2;++d0){s16x4 lo[4],hi[4];
    #pragma unroll
    for(int ks=0;ks<4;++ks){
      asm volatile("ds_read_b64_tr_b16 %0,%1 offset:%c2":"=&v"(lo[ks]):"v"(vb),"i"(d0*4096+ks*1024):"memory");
      asm volatile("ds_read_b64_tr_b16 %0,%1 offset:%c2":"=&v"(hi[ks]):"v"(vb),"i"(d0*4096+ks*1024+512):"memory");}
    asm volatile("s_waitcnt lgkmcnt(0)":::"memory");SBAR();
    #define PK(k) (bf16x8){lo[k][0],lo[k][1],lo[k][2],lo[k][3],hi[k][0],hi[k][1],hi[k][2],hi[k][3]}
    o[d0]=__builtin_amdgcn_mfma_f32_32x32x16_bf16(pa0,PK(0),o[d0],0,0,0);
    o[d0]=__builtin_amdgcn_mfma_f32_32x32x16_bf16(pa1,PK(1),o[d0],0,0,0);
    o[d0]=__builtin_amdgcn_mfma_f32_32x32x16_bf16(pa2,PK(2),o[d0],0,0,0);
    o[d0]=__builtin_amdgcn_mfma_f32_32x32x16_bf16(pa3,PK(3),o[d0],0,0,0);
    #undef PK
  }
}

#ifndef ATTN_STORE16
#define ATTN_STORE16(p,v) (*(u32x4*)(p)=(v))
#endif
typedef float f32x4_t __attribute__((ext_vector_type(4)));
typedef __attribute__((address_space(3))) const float* lds_fptr;
typedef __attribute__((address_space(3))) const f32x4_t* lds_f4p;
template<int THRL> __device__ __forceinline__ void attn_unit(int b,int h,int qb,int t0,const bf16*Q,const bf16*__restrict__ K,const bf16*__restrict__ V,bf16*O,char*shm){
  const int tid=mk_tid(),lane=tid&63,r32=lane&31,hi=lane>>5; const int wid=__builtin_amdgcn_readfirstlane(tid>>6);
  const long rowbase=(long)b*SEQ; const int q0=qb*QB;
  const bf16*Qw=Q+(rowbase+q0+wid*QBLK)*DM+h*D;
  const bf16*Kh=K+(rowbase+(long)t0*KVBLK)*DM+h*D,*Vh=V+(rowbase+(long)t0*KVBLK)*DM+h*D;
  const unsigned lds0=(unsigned)(uintptr_t)shm;
  float*wsf=(float*)(shm+LDS_WS)+wid*64;
  const bf16*ksrc=Kh+(long)lane*DM+wid*8;
  const bf16*vsrc=Vh+(long)(16*(wid&3)+(lane>>2))*DM+(wid>>2)*32+(lane&3)*8;
  const unsigned kdst=lds0+LDS_K+wid*1024, vdst=lds0+LDS_V+wid*1024;
  #define DMA_K(t,slot) glds16(ksrc+(long)(t)*KVBLK*DM,(unsigned)__builtin_amdgcn_readfirstlane(kdst+(slot)))
  #define DMA_V(t,slot) glds16(vsrc+(long)(t)*KVBLK*DM,(unsigned)__builtin_amdgcn_readfirstlane(vdst+(slot)))
  const int vb0=(int)(lds0+LDS_V)+((lane>>4)&1)*32+(lane&3)*8+(4*hi+((lane&15)>>2))*64;
  const char*Kbase=shm+LDS_K; bf16x8 kf[8];
  const lds_cptr shm3=(lds_cptr)shm; const lds_cptr kp0=shm3+LDS_K+hi*1024+r32*16; const lds_cptr vp0=shm3+LDS_V+((lane>>4)&1)*32+(lane&3)*8+(4*hi+((lane&15)>>2))*64;
  const int NT=(q0+QB)/KVBLK-t0;
  DMA_K(0,0);DMA_V(0,0);DMA_K(1,SLOTB);
  bf16x8 qr[4];
  #pragma unroll
  for(int d0=0;d0<4;++d0)qr[d0]=*reinterpret_cast<const bf16x8*>(&Qw[(long)r32*DM+d0*16+hi*8]);
  float mhat=0.f,l_reg=0.f;f32x16 o[2];o[0]=f32x16{};o[1]=f32x16{};const f32x16 negm=f32x16{};
  const int qrel=wid*QBLK+r32;
  #define CMASK(P0,P1,t) do{int jb_=(t)-(NT-4); if(jb_>=0)cmask(P0,P1,jb_,qrel,hi);}while(0)
  typedef unsigned u32x2_t __attribute__((ext_vector_type(2)));
  const unsigned K2=hi?0u:0x3F803F80u;
  const lds_cptr ext_lane=(lds_cptr)shm+(hi?LDS_EXTZ:(LDS_EXT+r32*8+t0*512)); const int ext_stride=hi?0:512;
  u32x2_t ke_a,ke_b; u32x4 qe; qe.x=K2; qe.y=hi?0u:0x3F80u; qe.z=0u; qe.w=0u;
  #define KEXT_LOAD(t) do{ const lds_cptr p_=ext_lane+(t)*ext_stride; ke_a=*(const __attribute__((address_space(3))) u32x2_t*)p_; ke_b=*(const __attribute__((address_space(3))) u32x2_t*)(p_+256); }while(0)
  #define KEXT_MMA(C0,C1) do{ const u32x4 a_={ke_a.x,ke_a.y,K2,0u}, b_={ke_b.x,ke_b.y,K2,0u}; \
    C0=__builtin_amdgcn_mfma_f32_32x32x16_bf16(__builtin_bit_cast(bf16x8,a_),__builtin_bit_cast(bf16x8,qe),negm,0,0,0); \
    C1=__builtin_amdgcn_mfma_f32_32x32x16_bf16(__builtin_bit_cast(bf16x8,b_),__builtin_bit_cast(bf16x8,qe),negm,0,0,0); }while(0)
  #define QEXT_UPDATE() do{ const float nm_=-mhat; const unsigned hb_=__float_as_uint(nm_)&0xffff0000u; const float r1_=nm_-__uint_as_float(hb_); \
    const unsigned mb_=__float_as_uint(r1_)&0xffff0000u; const float r2_=r1_-__uint_as_float(mb_); const unsigned lb_=cvtpk_s(r2_,0.f)&0xffffu; \
    qe.y=hi?0u:(hb_|0x3F80u); qe.z=hi?0u:((lb_<<16)|(mb_>>16)); }while(0)
  bool resc=false;
  #define START(P0,P1) do{ const float rm=rowmax(P0,P1); resc=false; \
    { const float dl=rm; mhat=fadd_s(mhat,dl); \
      _Pragma("unroll") for(int r=0;r<16;++r){P0[r]=fsub_s(P0[r],dl);P1[r]=fsub_s(P1[r],dl);} \
      } \
    _Pragma("unroll") for(int r=0;r<16;++r)P0[r]=__builtin_amdgcn_exp2f(P0[r]); }while(0)
  #define RESC() do{ if(resc){ asm volatile("s_waitcnt lgkmcnt(0)":::"memory"); \
      _Pragma("unroll") for(int d_=0;d_<2;++d_) _Pragma("unroll") for(int r=0;r<16;++r)o[d_][r]*=wsf[crow(r,hi)]; } }while(0)
  f32x16 pA0,pA1,pB0,pB1;
  int sl_prev=0,sl_cur=0,sl_next=SLOTB;
  #define ROT() do{sl_prev=sl_cur;sl_cur=sl_next;sl_next=(sl_next==(NSLOT-1)*SLOTB)?0:sl_next+SLOTB;}while(0)
  DMA_K(2,2*SLOTB);
  WAIT_BAR(3);
  KEXT_LOAD(0);KEXT_MMA(pA0,pA1);qkt(pA0,pA1,Kbase,qr,negm,r32,hi);asm volatile("s_nop 15\n\ts_nop 7":"+v"(pA0),"+v"(pA1));CMASK(pA0,pA1,0);
  START(pA0,pA1); QEXT_UPDATE(); KEXT_LOAD(1);
  _Pragma("unroll") for(int r=0;r<16;++r)pA1[r]=__builtin_amdgcn_exp2f(pA1[r]);
  WAIT_BAR(0);
  DMA_K(3,0);DMA_V(1,SLOTB);
  ROT();
  kload8(kf,kp0+sl_cur);
  WAIT_BAR(2);
  s16x4 vlo[8],vhi[8]; u32x4 pw0,pw1,pw2,pw3;
  #define PKW(P,B) cvtpk_s(P[B],P[B+1])
  #define PAF(k) __builtin_bit_cast(bf16x8,pw##k)
  #define VFR(i) (bf16x8){vlo[i][0],vlo[i][1],vlo[i][2],vlo[i][3],vhi[i][0],vhi[i][1],vhi[i][2],vhi[i][3]}
  #define PIN(x) asm volatile("":"+v"(x))
  #define MX3(a,b,c) __builtin_fmaxf(__builtin_fmaxf((a),(b)),(c))
  #define GAPA(MF,A0,A1,A2,A3,W0,W1,PW) do{ MF; sacc+=A0; sacc+=A1; sacc+=A2; sacc+=A3; PIN(sacc); W0; W1; PIN(PW); SBAR(); }while(0)
  #define EX(v) __builtin_amdgcn_exp2f(v)
  #define GAPB(MF,X,B) do{ MF; X[B]=EX(X[B]); X[B+1]=EX(X[B+1]); X[B+2]=EX(X[B+2]); X[B+3]=EX(X[B+3]); PIN(X); SBAR(); }while(0)
  #define VRD(i) do{ vlo[i]=vtr(vp_+(((i)>>2)*4096+((i)&3)*1024)); vhi[i]=vtr(vp_+(((i)>>2)*4096+((i)&3)*1024+512)); }while(0)
  #define KRD(G,j) do{ if(G){ kload2(kf,kp0+sl_next,j); SBAR(); } }while(0)
  #define STEP(C0,C1,P0,P1,t,GK,GV,GL) do{ SBAR(); \
    const lds_cptr vp_=vp0+sl_prev; \
    KEXT_MMA(C0,C1); SBAR(); \
    VRD(0); SBAR(); float sacc=(P0[0]+P0[1]); \
    GAPA(C0=__builtin_amdgcn_mfma_f32_32x32x16_bf16(kf[0],qr[0],C0,0,0,0), P0[2],P0[3],P0[4],P0[5],     pw0[0]=PKW(P0,0), pw0[1]=PKW(P0,2), pw0); \
    VRD(4); SBAR(); GAPA(C1=__builtin_amdgcn_mfma_f32_32x32x16_bf16(kf[1],qr[0],C1,0,0,0), P0[6],P0[7],P0[8],P0[9],     pw0[2]=PKW(P0,4), pw0[3]=PKW(P0,6), pw0); \
    VRD(1); SBAR(); GAPA(C0=__builtin_amdgcn_mfma_f32_32x32x16_bf16(kf[2],qr[1],C0,0,0,0),   P0[10],P0[11],P0[12],P0[13], pw1[0]=PKW(P0,8), pw1[1]=PKW(P0,10), pw1); \
    VRD(5); SBAR(); GAPA(C1=__builtin_amdgcn_mfma_f32_32x32x16_bf16(kf[3],qr[1],C1,0,0,0),   P0[14],P0[15],P1[0],P1[1],   pw1[2]=PKW(P0,12),pw1[3]=PKW(P0,14), pw1); \
    VRD(2); SBAR(); GAPA(C0=__builtin_amdgcn_mfma_f32_32x32x16_bf16(kf[4],qr[2],C0,0,0,0),   P1[2],P1[3],P1[4],P1[5],     pw2[0]=PKW(P1,0), pw2[1]=PKW(P1,2), pw2); \
    VRD(6); SBAR(); GAPA(C1=__builtin_amdgcn_mfma_f32_32x32x16_bf16(kf[5],qr[2],C1,0,0,0),   P1[6],P1[7],P1[8],P1[9],     pw2[2]=PKW(P1,4), pw2[3]=PKW(P1,6), pw2); \
    VRD(3); SBAR(); GAPA(C0=__builtin_amdgcn_mfma_f32_32x32x16_bf16(kf[6],qr[3],C0,0,0,0),   P1[10],P1[11],P1[12],P1[13], pw3[0]=PKW(P1,8), pw3[1]=PKW(P1,10), pw3); \
    VRD(7); SBAR(); GAPA(C1=__builtin_amdgcn_mfma_f32_32x32x16_bf16(kf[7],qr[3],C1,0,0,0),   P1[14],P1[15],0.f,0.f,       pw3[2]=PKW(P1,12),pw3[3]=PKW(P1,14), pw3); \
    l_reg+=sacc; \
    if(GK){DMA_K((t)+3,sl_cur);} if(GV){DMA_V((t)+1,sl_next);} \
    CMASK(C0,C1,t); \
    { float a=MX3(C0[0],C0[1],C1[0]),b=MX3(C0[2],C0[3],C1[1]); a=MX3(a,C1[2],C1[3]); \
      _Pragma("unroll") for(int r=4;r<16;r+=4){a=MX3(a,C0[r],C0[r+1]);b=MX3(b,C0[r+2],C0[r+3]);a=MX3(a,C1[r],C1[r+1]);b=MX3(b,C1[r+2],C1[r+3]);} \
      float rm=__builtin_fmaxf(a,b); { auto rr=__builtin_amdgcn_permlane32_swap(__float_as_uint(rm),__float_as_uint(rm),false,false); rm=__builtin_fmaxf(__uint_as_float(rr[0]),__uint_as_float(rr[1])); } \
      resc=false; \
      if(__builtin_expect(__any(rm>(float)THRL),0)){ const float dl=__builtin_fmaxf(rm,0.f); mhat+=dl; QEXT_UPDATE(); \
        _Pragma("unroll") for(int r=0;r<16;++r){C0[r]-=dl;C1[r]-=dl;} \
        const float f=__builtin_amdgcn_exp2f(-dl); l_reg*=f; if(hi==0)wsf[r32]=f; resc=true; } } \
    SBAR(); \
    GAPB(o[0]=__builtin_amdgcn_mfma_f32_32x32x16_bf16(PAF(0),VFR(0),o[0],0,0,0), C0,0); \
    GAPB(o[1]=__builtin_amdgcn_mfma_f32_32x32x16_bf16(PAF(0),VFR(4),o[1],0,0,0), C0,4); \
    KRD(GL,0); if(GL){KEXT_LOAD((t)+1); SBAR();} GAPB(o[0]=__builtin_amdgcn_mfma_f32_32x32x16_bf16(PAF(1),VFR(1),o[0],0,0,0), C0,8); \
    KRD(GL,1); GAPB(o[1]=__builtin_amdgcn_mfma_f32_32x32x16_bf16(PAF(1),VFR(5),o[1],0,0,0), C0,12); \
    KRD(GL,2); GAPB(o[0]=__builtin_amdgcn_mfma_f32_32x32x16_bf16(PAF(2),VFR(2),o[0],0,0,0), C1,0); \
    KRD(GL,3); GAPB(o[1]=__builtin_amdgcn_mfma_f32_32x32x16_bf16(PAF(2),VFR(6),o[1],0,0,0), C1,4); \
    GAPB(o[0]=__builtin_amdgcn_mfma_f32_32x32x16_bf16(PAF(3),VFR(3),o[0],0,0,0), C1,8); \
    GAPB(o[1]=__builtin_amdgcn_mfma_f32_32x32x16_bf16(PAF(3),VFR(7),o[1],0,0,0), C1,12); \
    }while(0)
  int t=1;
  #undef CMASK
  #define CMASK(P0,P1,t) do{}while(0)
  for(;t+5<NT;t+=2){
    STEP(pB0,pB1,pA0,pA1,t,true,true,true);     WAIT_BAR(2); RESC(); ROT();
    STEP(pA0,pA1,pB0,pB1,t+1,true,true,true);   WAIT_BAR(2); RESC(); ROT();
  }
  #undef CMASK
  #define CMASK(P0,P1,t) do{int jb_=(t)-(NT-4); if(jb_>=0)cmask(P0,P1,jb_,qrel,hi);}while(0)
  #define ENDW(tt) do{ if((tt)+3<NT){WAIT_BAR(2);} else if((tt)+2<NT){WAIT_BAR(1);} else {WAIT_BAR(0);} }while(0)
  for(;t+1<NT;t+=2){
    STEP(pB0,pB1,pA0,pA1,t,(t+3<NT),(t+1<NT),(t+1<NT));       ENDW(t);   RESC(); ROT();
    STEP(pA0,pA1,pB0,pB1,t+1,(t+4<NT),(t+2<NT),(t+2<NT));     ENDW(t+1); RESC(); ROT();
  }
  STEP(pB0,pB1,pA0,pA1,NT-1,false,false,false); RESC();
  { float sacc=pB0[0]+pB0[1]; _Pragma("unroll") for(int r=2;r<16;++r)sacc+=pB0[r]; _Pragma("unroll") for(int r=0;r<16;++r)sacc+=pB1[r]; l_reg+=sacc;
    pw0=(u32x4){PKW(pB0,0),PKW(pB0,2),PKW(pB0,4),PKW(pB0,6)};pw1=(u32x4){PKW(pB0,8),PKW(pB0,10),PKW(pB0,12),PKW(pB0,14)};pw2=(u32x4){PKW(pB1,0),PKW(pB1,2),PKW(pB1,4),PKW(pB1,6)};pw3=(u32x4){PKW(pB1,8),PKW(pB1,10),PKW(pB1,12),PKW(pB1,14)};
    SBAR(); pv(o,vb0+sl_cur,PAF(0),PAF(1),PAF(2),PAF(3)); }
  #undef PKW
  #undef PAF
  #undef VFR
  #undef PIN
  #undef MX3
  #undef GAPA
  #undef GAPB
  #undef EX
  #undef VRD
  #undef KRD
  #undef STEP
  #undef ENDW
  {auto rr=__builtin_amdgcn_permlane32_swap(__float_as_uint(l_reg),__float_as_uint(l_reg),false,false);l_reg=__uint_as_float(rr[0])+__uint_as_float(rr[1]);}
  if(hi==0)wsf[32+r32]=l_reg;asm volatile("s_waitcnt lgkmcnt(0)":::"memory");
  float rli[16];
  #pragma unroll
  for(int r=0;r<16;++r)rli[r]=__builtin_amdgcn_rcpf(wsf[32+crow(r,hi)]);
  bf16*Ow=O+(rowbase+q0+wid*QBLK)*OP+h*D;
  { bf16*stg=(bf16*)(shm+LDS_OST)+wid*2048;
    #pragma unroll
    for(int r=0;r<16;++r){const int orow=crow(r,hi);
      #pragma unroll
      for(int d0=0;d0<2;++d0)stg[orow*64+d0*32+r32]=__float2bfloat16(o[d0][r]*rli[r]);}
    asm volatile("s_waitcnt lgkmcnt(0)":::"memory");
    #pragma unroll
    for(int i=0;i<4;++i){const int row=i*8+(lane>>3),ch=lane&7; const u32x4 v=*(const u32x4*)(stg+row*64+ch*8); ATTN_STORE16(Ow+(long)row*OP+ch*8,v);} }
  asm volatile("s_waitcnt lgkmcnt(0)\n\ts_barrier":::"memory");
  #undef KEXT_LOAD
  #undef KEXT_MMA
  #undef QEXT_UPDATE
  #undef DMA_K
  #undef DMA_V
  #undef CMASK
  #undef START
  #undef RESC
  #undef ROT
}
constexpr int ATTN_LDS_BYTES=LDS_BYTES;
struct AttnTensors { const bf16* Q; const bf16* K; const bf16* V; bf16* O; };
struct AttnTensors_dummy_{};
constexpr float PRUNE_THR=40.0f;
constexpr int LDS_BQ=LDS_CBW+64, LDS_T0=LDS_BQ+64, LDS_NRM=LDS_T0+64;
typedef __bf16 bf16x2_t2 __attribute__((ext_vector_type(2)));
__device__ __forceinline__ float sumsq8(const u32x4 r){ float s=0.f;
  #pragma unroll
  for(int q=0;q<4;++q){ const bf16x2_t2 p=__builtin_bit_cast(bf16x2_t2,r[q]); s=__builtin_amdgcn_fdot2_f32_bf16(p,p,s,false); } return s; }
__device__ __forceinline__ float dot8(const u32x4 a,const u32x4 b){ float s=0.f;
  #pragma unroll
  for(int q=0;q<4;++q) s=__builtin_amdgcn_fdot2_f32_bf16(__builtin_bit_cast(bf16x2_t2,a[q]),__builtin_bit_cast(bf16x2_t2,b[q]),s,false); return s; }
__device__ __forceinline__ float sum8lanes(float s){
  s+=__builtin_bit_cast(float,__builtin_amdgcn_update_dpp(0,__builtin_bit_cast(int,s),0xB1,0xF,0xF,true));
  s+=__builtin_bit_cast(float,__builtin_amdgcn_update_dpp(0,__builtin_bit_cast(int,s),0x4E,0xF,0xF,true));
  s+=__builtin_bit_cast(float,__builtin_amdgcn_update_dpp(0,__builtin_bit_cast(int,s),0x141,0xF,0xF,true)); return s; }
__device__ __forceinline__ int unit_qb(int i,int s){ return (i==0)?(15-s):(i==1)?(8+s):(i==2)?(7-s):s; }
__device__ __forceinline__ void cb_fill(char*lds,const float*logf,const bf16*Q,const bf16*K,int b,int h,int s4,unsigned*gx){
  const int tid=mk_tid(),lane=tid&63; const int wid=__builtin_amdgcn_readfirstlane(tid>>6);
  typedef unsigned u32x2_t __attribute__((ext_vector_type(2)));
  u32x2_t*ext=(u32x2_t*)(lds+LDS_EXT); float*wt=(float*)(lds+LDS_CBW); float*bq=(float*)(lds+LDS_BQ); int*t0s=(int*)(lds+LDS_T0); float*nrm=(float*)(lds+LDS_NRM);
  float v[8]; const float*src=logf+((size_t)b*SEQ+(size_t)tid*8)*NHEAD+h;
  #pragma unroll
  for(int i=0;i<8;++i)v[i]=src[i*NHEAD];
  float q2b[4]={0.f,0.f,0.f,0.f},dmn[4]={3.0e38f,3.0e38f,3.0e38f,3.0e38f},k2=0.f;
  { const bf16*qp=Q+((size_t)b*SEQ+(tid>>3))*DM+h*D+(tid&7)*8; const bf16*kp=K+((size_t)b*SEQ+(tid>>3))*DM+h*D+(tid&7)*8;
    #pragma unroll
    for(int i=0;i<4;++i){ const bf16*qq=qp+(size_t)unit_qb(i,s4)*QB*DM;
      #pragma unroll
      for(int it=0;it<4;++it){ const u32x4 qv=*(const u32x4*)(qq+(size_t)it*64*DM), kv=*(const u32x4*)(kp+((size_t)unit_qb(i,s4)*QB+(size_t)it*64)*DM);
        q2b[i]=fmaxf(q2b[i],sum8lanes(sumsq8(qv))); dmn[i]=fminf(dmn[i],sum8lanes(dot8(qv,kv))); } }
    const int k_lo=gx?s4*(SEQ/4):0, k_n=gx?(SEQ/4)/64:SEQ/64;
    #pragma unroll 8
    for(int it=0;it<k_n;++it) k2=fmaxf(k2,sum8lanes(sumsq8(*(const u32x4*)(kp+((size_t)k_lo+(size_t)it*64)*DM))));
    #pragma unroll
    for(int o=8;o<64;o<<=1){ k2=fmaxf(k2,__shfl_xor(k2,o));
      #pragma unroll
      for(int i=0;i<4;++i){q2b[i]=fmaxf(q2b[i],__shfl_xor(q2b[i],o));dmn[i]=fminf(dmn[i],__shfl_xor(dmn[i],o));} } }
  #pragma unroll
  for(int i=1;i<8;++i)v[i]+=v[i-1];
  const float tot=v[7]; float inc=tot;
  #pragma unroll
  for(int o=1;o<64;o<<=1){const float t=__shfl_up(inc,o); if(lane>=o)inc+=t;}
  if(lane==63)wt[wid]=inc;
  if(lane==0){ nrm[wid*9+8]=k2;
    #pragma unroll
    for(int i=0;i<4;++i){nrm[wid*9+i]=q2b[i];nrm[wid*9+4+i]=dmn[i];} }
  if(tid<16)t0s[tid]=0;
  __syncthreads();
  float base=inc-tot; for(int w=0;w<wid;++w)base+=wt[w];
  if(tid==0){ float m[5]={0.f,0.f,0.f,0.f,0.f},dm[4]={3.0e38f,3.0e38f,3.0e38f,3.0e38f};
    for(int w=0;w<8;++w){ m[4]=fmaxf(m[4],nrm[w*9+8]);
      #pragma unroll
      for(int i=0;i<4;++i){m[i]=fmaxf(m[i],nrm[w*9+i]);dm[i]=fminf(dm[i],nrm[w*9+4+i]);} }
    if(gx){
      (void)__hip_atomic_fetch_max(gx,__float_as_uint(m[4]),__ATOMIC_RELAXED,__HIP_MEMORY_SCOPE_AGENT);
      asm volatile("s_waitcnt vmcnt(0)":::"memory");
      (void)__hip_atomic_fetch_add(gx+1,1u,__ATOMIC_RELAXED,__HIP_MEMORY_SCOPE_AGENT);
      unsigned sp=0; while(__hip_atomic_load(gx+1,__ATOMIC_RELAXED,__HIP_MEMORY_SCOPE_AGENT)<4u){ __builtin_amdgcn_s_sleep(2); if(++sp>(1u<<22))break; }
      m[4]=(sp>(1u<<22))?3.0e38f:__uint_as_float(__hip_atomic_load(gx,__ATOMIC_RELAXED,__HIP_MEMORY_SCOPE_AGENT)); }
    #pragma unroll
    for(int i=0;i<5;++i)nrm[80+i]=m[i];
    #pragma unroll
    for(int i=0;i<4;++i)nrm[85+i]=dm[i]; }
  float cs[8];
  #pragma unroll
  for(int i=0;i<8;++i){ const float c=-(base+v[i])*1.4426950408889634f; cs[i]=c; const unsigned hb=__float_as_uint(c)&0xffff0000u; const float r1=c-__uint_as_float(hb);
    const unsigned mb=__float_as_uint(r1)&0xffff0000u; const float r2=r1-__uint_as_float(mb); const unsigned lb=cvtpk_s(r2,0.f)&0xffffu;
    u32x2_t e; e.x=mb|(hb>>16); e.y=0x3F800000u|lb; ext[tid*8+i]=e; }
  if(tid<128)((unsigned*)(lds+LDS_EXTZ))[tid]=0u;
  if((tid&31)==0)bq[tid>>5]=cs[0];
  __syncthreads();
  if((tid&7)==7){ const int t=tid>>3; const float mb_=cs[7]; const float k2m=nrm[84];
    #pragma unroll
    for(int i=0;i<4;++i){ const int qb=unit_qb(i,s4); const float limit=PRUNE_THR+1.0f+__builtin_sqrtf(fminf(nrm[80+i]*k2m,1.0e37f))*1.001f-nrm[85+i];
      if(t<4*qb && mb_<bq[qb]-limit) atomicAdd(&t0s[qb],1); } }
  __syncthreads();
}
template<int THRL=8> __device__ __forceinline__ void attn_phase(char*lds,const AttnTensors&T,const float*logf,int G,int vcu,unsigned*gxl){
  for(int v=vcu;v<256;v+=G){
    const int bh=v>>2,s=v&3,b=bh>>3,h=bh&7;
    cb_fill(lds,logf,T.Q,T.K,b,h,s,(G==256)?gxl+bh*2:nullptr);
    for(int i=0;i<4;++i){ const int qb=unit_qb(i,s);
      int t0=((const int*)(lds+LDS_T0))[qb]; t0=(t0>4*qb?4*qb:t0)&~1; t0=__builtin_amdgcn_readfirstlane(t0);
      attn_unit<THRL>(b,h,qb,t0,T.Q,T.K,T.V,T.O,lds); }
  }
}
#undef SBAR
#undef WAIT_BAR
}
#define GAS __attribute__((address_space(1)))
#define LAS __attribute__((address_space(3)))
typedef unsigned short bf16;
typedef unsigned v4u __attribute__((ext_vector_type(4)));
typedef float f32x4 __attribute__((ext_vector_type(4)));
typedef short bf16x8 __attribute__((ext_vector_type(8)));
constexpr int NWAVES = 8;
constexpr int BATCH = 8, SEQ = 4096, DM = 1024, DEPTH = 4, NH = 8, HD = 64, DATT = 512, DREC = 512, DFF = 2816, DIN = 2568;
constexpr int T = BATCH * SEQ;
constexpr int ZP = 2560;
constexpr float EPS = 1e-6f;
constexpr size_t MiB = 1u << 20;
constexpr size_t WS_WFI = 0, WS_WFO = 88 * MiB, WS_WIN = 132 * MiB, WS_WO = 152 * MiB, WS_XN = 160 * MiB, WS_Y = 224 * MiB, WS_ACT = 288 * MiB  ,
                 WS_LOGF = 464 * MiB, WS_SUM = 466 * MiB, WS_CTL = 468 * MiB, CTL_BYTES = 65536, WS_SSQ = 469 * MiB, WS_WFT = 471 * MiB, WS_END = 472 * MiB;
static_assert((size_t)DEPTH * 2 * 2 * DFF * DM * 2 == 88 * MiB && (size_t)DEPTH * 2 * DM * DFF * 2 == 44 * MiB && (size_t)DEPTH * ZP * DM * 2 == 20 * MiB, "weights map");
static_assert((size_t)T * DFF * 2 == 176 * MiB && (size_t)T * ZP * 2 <= 176 * MiB, "act map");
constexpr int RING_BYTES = 131072, MISC_OFF = RING_BYTES + 320, LDS_BYTES = 147456;

__device__ __forceinline__ unsigned f2bf(float f) { unsigned u = __builtin_bit_cast(unsigned, f); return (u + 0x7fffu + ((u >> 16) & 1u)) >> 16; }
__device__ __forceinline__ unsigned pk2(float lo, float hi) { return f2bf(lo) | (f2bf(hi) << 16); }
#define LDS_WAIT() asm volatile("s_waitcnt lgkmcnt(0)" ::: "memory")
__device__ __forceinline__ float wave_sum(float v) {
#pragma unroll
    for (int o = 1; o < 64; o <<= 1) v += __shfl_xor(v, o);
    return v;
}
#define RLX_AGENT __ATOMIC_RELAXED, __HIP_MEMORY_SCOPE_AGENT
#define XB_TMO      128
#define XB_XCNT(j)  (256  + 64 * (j))
#define XB_XSUB(j)  (1280 + 64 * (j))
#define XB_XGEN(j)  (2304 + 64 * (j))
#define XB_TOP      3328
#define XB_TOPGEN   3392
#define XCD_BAR_WORDS 3456
#define XB_SPIN_CAP (1u << 18)

__device__ __forceinline__ unsigned xb_ld(unsigned* p)              { return __hip_atomic_load(p, __ATOMIC_RELAXED, __HIP_MEMORY_SCOPE_AGENT); }
__device__ __forceinline__ unsigned xb_add(unsigned* p, unsigned v) { return __hip_atomic_fetch_add(p, v, __ATOMIC_RELAXED, __HIP_MEMORY_SCOPE_AGENT); }
__device__ __forceinline__ unsigned xb_xcc_id() { return (unsigned)__builtin_amdgcn_s_getreg((3 << 11) | 20) & 0xFu; }
#define XB_SPIN(cond, bar) do { unsigned _sp = 0; while (cond) { __builtin_amdgcn_s_sleep(1); \
    if ((++_sp & 255u) == 0u) { if (xb_ld(&(bar)[XB_TMO])) break; if (_sp > XB_SPIN_CAP) { atomicAdd(&(bar)[XB_TMO], 1u); break; } } } } while (0)

struct XcdBarrier {
    unsigned* bar; unsigned x;
    volatile LAS unsigned* st;
};

__device__ __forceinline__ XcdBarrier xcd_barrier_post(unsigned* bar, volatile LAS unsigned* st) {
    XcdBarrier b; b.bar = bar; b.x = xb_xcc_id(); b.st = st;
    if (threadIdx.x == 0) (void)xb_add(&bar[XB_XCNT(b.x)], 1u);
    return b;
}
__device__ __forceinline__ void xcd_barrier_complete(unsigned* bar, unsigned x, unsigned& nloc, unsigned& nx) {
    const unsigned G = gridDim.x * gridDim.y * gridDim.z;
    unsigned sum, cnt, mine, sp = 0u;
    for (;;) {
        sum = 0u; cnt = 0u; mine = 0u;
#pragma unroll
        for (unsigned j = 0; j < 16; ++j) { const unsigned c = xb_ld(&bar[XB_XCNT(j)]); sum += c; cnt += (c > 0u) ? 1u : 0u; mine = (j == x) ? c : mine; }
        if (sum == G) break;
        __builtin_amdgcn_s_sleep(1);
        if ((++sp & 255u) == 0u) { if (xb_ld(&bar[XB_TMO])) break; if (sp > XB_SPIN_CAP) { atomicAdd(&bar[XB_TMO], 1u); break; } }
    }
    nloc = mine > 0u ? mine : 1u; nx = cnt > 0u ? cnt : 1u;
}

__device__ __forceinline__ void xcd_barrier(const XcdBarrier& b) {
    asm volatile("s_waitcnt vmcnt(0)" ::: "memory");
    __syncthreads();
    if (threadIdx.x == 0) {
        unsigned* bar = b.bar;
        __builtin_amdgcn_s_waitcnt(0);
        unsigned nloc = b.st[0], nx = b.st[1];
        if (nloc == 0u) { xcd_barrier_complete(bar, b.x, nloc, nx); b.st[0] = nloc; b.st[1] = nx; }
        const unsigned old = xb_add(&bar[XB_XSUB(b.x)], 1u);
        const unsigned gen = old / nloc;
        if (old + 1u == (gen + 1u) * nloc) {
            __builtin_amdgcn_fence(__ATOMIC_RELEASE, "agent");
            asm volatile("s_waitcnt vmcnt(0)" ::: "memory");
            const unsigned og = xb_add(&bar[XB_TOP], 1u);
            const unsigned tg = og / nx;
            if (og + 1u == (tg + 1u) * nx) xb_add(&bar[XB_TOPGEN], 1u);
            else XB_SPIN(xb_ld(&bar[XB_TOPGEN]) == tg, bar);
            __builtin_amdgcn_fence(__ATOMIC_ACQUIRE, "agent");
            xb_add(&bar[XB_XGEN(b.x)], 1u);
            asm volatile("s_waitcnt vmcnt(0)" ::: "memory");
        } else {
            XB_SPIN(xb_ld(&bar[XB_XGEN(b.x)]) == gen, bar);
            __builtin_amdgcn_fence(__ATOMIC_ACQUIRE, "agent");
            asm volatile("s_waitcnt vmcnt(0)" ::: "memory");
        }
    }
    __syncthreads();
}

struct Args { const float* in[15]; float* out; unsigned char* ws; int ph_lo, ph_hi; };
enum { I_X = 0, I_NG, I_WIN, I_BF, I_CW, I_CB, I_WA, I_BA, I_WX, I_BX, I_LAM, I_WO, I_WFI, I_WFO, I_FG };

struct TItem { const float* src; const float* gk; bf16* dst; int ldw, K; };
__device__ __forceinline__ TItem titem(const __attribute__((address_space(4))) Args* ap_, int it) {
    unsigned char* ws = ap_->ws; TItem d;
    constexpr int N_FI = 2 * 16 * 176, N_FO = 2 * 44 * 32, N_IN = 16 * 80, N_O = 16 * 32, N_L = N_FI + N_FO + N_IN + N_O;
    const int l = it / N_L; int r = it % N_L;
    if (r < N_FI) { const int j = r / (16 * 176); r %= (16 * 176); const int kb = r / 176, nb = r % 176; const int n = 32 * nb, k0 = 64 * kb;
        const int dst = (n < DFF) ? ((n / 128) * 256 + (n % 128)) : (((n - DFF) / 128) * 256 + 128 + ((n - DFF) % 128));
        d.src = ap_->in[I_WFI] + (size_t)(l * 2 + j) * DM * 2 * DFF + (size_t)k0 * (2 * DFF) + n; d.ldw = 2 * DFF; d.K = DM; d.gk = ap_->in[I_NG] + (size_t)(l * 3 + 2 * j) * DM + k0;
        d.dst = (bf16*)(ws + WS_WFI) + (size_t)(l * 2 + j) * 2 * DFF * DM + (size_t)dst * DM + k0; return d; }
    r -= N_FI;
    if (r < N_FO) { const int j = r / (44 * 32); r %= (44 * 32); const int kb = r / 32, nb = r % 32; const int n = 32 * nb, k0 = 64 * kb;
        d.src = ap_->in[I_WFO] + (size_t)(l * 2 + j) * DFF * DM + (size_t)k0 * DM + n; d.ldw = DM; d.K = DFF; d.gk = nullptr;
        d.dst = (bf16*)(ws + WS_WFO) + (size_t)(l * 2 + j) * DM * DFF + (size_t)n * DFF + k0; return d; }
    r -= N_FO;
    if (r < N_IN) { const int kb = r / 80, nb = r % 80; const int n = 32 * nb, k0 = 64 * kb;
        d.src = ap_->in[I_WIN] + (size_t)l * DM * DIN + (size_t)k0 * DIN + ((n < 3 * DATT) ? n : n + NH); d.ldw = DIN; d.K = DM; d.gk = ap_->in[I_NG] + (size_t)(l * 3 + 1) * DM + k0;
        d.dst = (bf16*)(ws + WS_WIN) + (size_t)l * ZP * DM + (size_t)n * DM + k0; return d; }
    r -= N_IN;
    { const int kb = r / 32, nb = r % 32; const int n = 32 * nb, k0 = 64 * kb;
        d.src = ap_->in[I_WO] + (size_t)l * DM * DM + (size_t)k0 * DM + n; d.ldw = DM; d.K = DM; d.gk = nullptr;
        d.dst = (bf16*)(ws + WS_WO) + (size_t)l * DM * DM + (size_t)n * DM + k0; return d; }
}
__device__ __forceinline__ void ti_load(const TItem& d, float (&w)[32], float (&g)[32], int lane) {
#pragma unroll
    for (int i = 0; i < 32; ++i) { const int kk = 2 * i + (lane >> 5); w[i] = d.src[(size_t)kk * d.ldw + (lane & 31)]; }
    if (d.gk) {
#pragma unroll
        for (int i = 0; i < 32; ++i) g[i] = d.gk[2 * i + (lane >> 5)];
    } else {
#pragma unroll
        for (int i = 0; i < 32; ++i) g[i] = 1.0f;
    }
}
__device__ __forceinline__ void ti_finish(const TItem& d, const float (&w)[32], const float (&g)[32], LAS float* scr, int lane) {
#pragma unroll
    for (int i = 0; i < 32; ++i) { const int kk = 2 * i + (lane >> 5); scr[kk * 33 + (lane & 31)] = w[i] * g[i]; }
    LDS_WAIT();
    const int c = lane & 7;
#pragma unroll
    for (int j = 0; j < 4; ++j) { const int n = (lane >> 3) + 8 * j; const LAS float* s = scr + (8 * c) * 33 + n;
        v4u o; o.x = pk2(s[0 * 33], s[1 * 33]); o.y = pk2(s[2 * 33], s[3 * 33]); o.z = pk2(s[4 * 33], s[5 * 33]); o.w = pk2(s[6 * 33], s[7 * 33]);
        *(GAS v4u*)(d.dst + (size_t)n * d.K + 8 * c) = o; }
    LDS_WAIT();
}
__device__ __forceinline__ void prologue_weights(const __attribute__((address_space(4))) Args* ap_, LAS unsigned char* lds, int gw, int NGW, int wave, int lane) {
    LAS float* scr = (LAS float*)(lds + wave * 16384);
    constexpr int N_ALL = DEPTH * (2 * 16 * 176 + 2 * 44 * 32 + 16 * 80 + 16 * 32);
    if (gw >= N_ALL) return;
    TItem cur = titem(ap_, gw); float wa[32], ga[32];
    ti_load(cur, wa, ga, lane);
    for (int it = gw; it < N_ALL; it += NGW) {
        const int nx = it + NGW; TItem nxt = cur; float wb[32], gb[32];
        if (nx < N_ALL) { nxt = titem(ap_, nx); ti_load(nxt, wb, gb, lane); }
        ti_finish(cur, wa, ga, scr, lane);
        cur = nxt;
#pragma unroll
        for (int i = 0; i < 32; ++i) { wa[i] = wb[i]; ga[i] = gb[i]; }
    }
}
template <bool WITH_F>
__device__ __forceinline__ void rms_phase(LAS unsigned char* lds, const float* x, const float* g, bf16* XN, const float* w_in_l, const float* b_f_l, float* LOGF, int gw, int NGW, int tid, int lane) {
    LAS float* WF0 = (LAS float*)lds; LAS float* WF1 = (LAS float*)(lds + 16384);
    if (WITH_F) {
        for (int idx = tid; idx < 8192; idx += NWAVES * 64) { const int k = idx >> 3, hh = idx & 7; const int slot = ((k >> 8) * 4 + (k & 3)) * 64 + ((k & 255) >> 2);
            const float w = w_in_l[(size_t)k * DIN + 3 * DATT + hh] * g[k]; (hh < 4 ? WF0 : WF1)[slot * 4 + (hh & 3)] = w; }
        __syncthreads();
    }
    f32x4 gv[4];
#pragma unroll
    for (int j = 0; j < 4; ++j) gv[j] = ((const f32x4*)g)[lane + 64 * j];
    for (int m = gw; m < T; m += NGW) {
        const f32x4* xr = (const f32x4*)(x + (size_t)m * DM) + lane;
        f32x4 v[4]; float ss = 0.f;
#pragma unroll
        for (int j = 0; j < 4; ++j) { v[j] = xr[64 * j]; ss += (v[j].x * v[j].x + v[j].y * v[j].y) + (v[j].z * v[j].z + v[j].w * v[j].w); }
        const float rstd = rsqrtf(wave_sum(ss) * (1.0f / DM) + EPS);
        unsigned long long* o8 = (unsigned long long*)(XN + (size_t)m * DM) + lane;
#pragma unroll
        for (int j = 0; j < 4; ++j) { const f32x4 o = v[j] * rstd * gv[j]; o8[64 * j] = (unsigned long long)pk2(o.x, o.y) | ((unsigned long long)pk2(o.z, o.w) << 32); }
        if (WITH_F) {
            f32x4 f0 = {0.f, 0.f, 0.f, 0.f}, f1 = {0.f, 0.f, 0.f, 0.f};
#pragma unroll
            for (int j = 0; j < 4; ++j)
#pragma unroll
                for (int i = 0; i < 4; ++i) { const int slot = (j * 4 + i) * 64 + lane; const f32x4 w0 = ((const LAS f32x4*)WF0)[slot], w1 = ((const LAS f32x4*)WF1)[slot]; const float xv = v[j][i]; f0 += w0 * xv; f1 += w1 * xv; }
            float z = 0.f;
#pragma unroll
            for (int hh = 0; hh < 8; ++hh) { const float s = wave_sum(hh < 4 ? f0[hh & 3] : f1[hh & 3]); if (lane == hh) z = s; }
            if (lane < 8) { z = z * rstd + b_f_l[lane]; const float nz = -z; const float sp = fmaxf(nz, 0.f) + log1pf(__expf(-fabsf(z))); LOGF[(size_t)m * NH + lane] = -sp; }
        }
    }
}
__device__ __forceinline__ void prologue_x(const float* x, bf16* XB, float* SSQ, const float* w_in, const float* ng, bf16* WFt, int gw, int NGW, int lane) {
    for (int m0 = 4 * gw; m0 < T; m0 += 4 * NGW) {
        f32x4 v[4][4]; float ss[4] = {0.f, 0.f, 0.f, 0.f};
#pragma unroll
        for (int q = 0; q < 4; ++q) { const f32x4* xr = (const f32x4*)(x + (size_t)(m0 + q) * DM) + lane;
#pragma unroll
            for (int j = 0; j < 4; ++j) v[q][j] = xr[64 * j]; }
#pragma unroll
        for (int q = 0; q < 4; ++q) {
#pragma unroll
            for (int j = 0; j < 4; ++j) ss[q] += (v[q][j].x * v[q][j].x + v[q][j].y * v[q][j].y) + (v[q][j].z * v[q][j].z + v[q][j].w * v[q][j].w);
            ss[q] = wave_sum(ss[q]);
            unsigned long long* o8 = (unsigned long long*)(XB + (size_t)(m0 + q) * DM) + lane;
#pragma unroll
            for (int j = 0; j < 4; ++j) o8[64 * j] = (unsigned long long)pk2(v[q][j].x, v[q][j].y) | ((unsigned long long)pk2(v[q][j].z, v[q][j].w) << 32);
            if (lane < 16) SSQ[(size_t)(m0 + q) * 16 + lane] = (lane == 0) ? ss[q] : 0.f; }
    }
    for (int idx = gw * 64 + lane; idx < DEPTH * 16 * DM; idx += NGW * 64) { const int l = idx / (16 * DM), r = idx % (16 * DM), hh = r / DM, k = r % DM;
        const float w = (hh < NH) ? w_in[(size_t)l * DM * DIN + (size_t)k * DIN + 3 * DATT + hh] * ng[(size_t)(l * 3 + 1) * DM + k] : 0.f; WFt[idx] = (bf16)f2bf(w); }
}
__device__ __forceinline__ void logf_phase(const bf16* XB, const float* SSQ, const bf16* WFt_l, const float* b_f_l, float* LOGF, int gw, int NGW, int lane) {
    const int fr = lane & 15, fq = lane >> 4;
    for (int rt = gw; rt < T / 16; rt += NGW) {
        const bf16* a = XB + (size_t)(rt * 16 + fr) * DM + 8 * fq; const bf16* b = WFt_l + (size_t)fr * DM + 8 * fq;
        f32x4 d = {0.f, 0.f, 0.f, 0.f};
#pragma unroll 16
        for (int ks = 0; ks < DM / 32; ++ks) { const bf16x8 av = *(const bf16x8*)(a + 32 * ks), bv = *(const bf16x8*)(b + 32 * ks); d = __builtin_amdgcn_mfma_f32_16x16x32_bf16(av, bv, d, 0, 0, 0); }
        if (fr < NH) { const float bias = b_f_l[fr];
#pragma unroll
            for (int i = 0; i < 4; ++i) { const int row = rt * 16 + 4 * fq + i; const float z = d[i] * pg8::row_rstd(SSQ, row) + bias; LOGF[(size_t)row * NH + fr] = -(fmaxf(-z, 0.f) + log1pf(__expf(-fabsf(z)))); } }
    }
}
__device__ __forceinline__ void rms_final(float* x, const float* g, int gw, int NGW, int lane) {
    f32x4 gv[4];
#pragma unroll
    for (int j = 0; j < 4; ++j) gv[j] = ((const f32x4*)g)[lane + 64 * j];
    for (int m = gw; m < T; m += NGW) {
        f32x4* xr = (f32x4*)(x + (size_t)m * DM) + lane;
        f32x4 v[4]; float ss = 0.f;
#pragma unroll
        for (int j = 0; j < 4; ++j) { v[j] = xr[64 * j]; ss += (v[j].x * v[j].x + v[j].y * v[j].y) + (v[j].z * v[j].z + v[j].w * v[j].w); }
        const float rstd = rsqrtf(wave_sum(ss) * (1.0f / DM) + EPS);
#pragma unroll
        for (int j = 0; j < 4; ++j) xr[64 * j] = v[j] * rstd * gv[j];
    }
}

__device__ __forceinline__ void rms_final_b(const bf16* X, float* o, const float* g, int gw, int NGW, int lane) {
    const f32x4 g0 = ((const f32x4*)g)[2 * lane], g1 = ((const f32x4*)g)[2 * lane + 1], g2 = ((const f32x4*)g)[128 + 2 * lane], g3 = ((const f32x4*)g)[128 + 2 * lane + 1];
    for (int m0 = 4 * gw; m0 < T; m0 += 4 * NGW) {
        v4u r0[4], r1[4];
#pragma unroll
        for (int q = 0; q < 4; ++q) { const v4u* xr = (const v4u*)(X + (size_t)(m0 + q) * DM) + lane; r0[q] = xr[0]; r1[q] = xr[64]; }
#pragma unroll
        for (int q = 0; q < 4; ++q) {
            const f32x4 a0 = {__uint_as_float(r0[q].x << 16), __uint_as_float(r0[q].x & 0xffff0000u), __uint_as_float(r0[q].y << 16), __uint_as_float(r0[q].y & 0xffff0000u)};
            const f32x4 a1 = {__uint_as_float(r0[q].z << 16), __uint_as_float(r0[q].z & 0xffff0000u), __uint_as_float(r0[q].w << 16), __uint_as_float(r0[q].w & 0xffff0000u)};
            const f32x4 b0 = {__uint_as_float(r1[q].x << 16), __uint_as_float(r1[q].x & 0xffff0000u), __uint_as_float(r1[q].y << 16), __uint_as_float(r1[q].y & 0xffff0000u)};
            const f32x4 b1 = {__uint_as_float(r1[q].z << 16), __uint_as_float(r1[q].z & 0xffff0000u), __uint_as_float(r1[q].w << 16), __uint_as_float(r1[q].w & 0xffff0000u)};
            const f32x4 sq = (a0 * a0 + a1 * a1) + (b0 * b0 + b1 * b1);
            const float rstd = rsqrtf(wave_sum((sq[0] + sq[1]) + (sq[2] + sq[3])) * (1.0f / DM) + EPS);
            f32x4* orow = (f32x4*)(o + (size_t)(m0 + q) * DM);
            orow[2 * lane] = a0 * rstd * g0; orow[2 * lane + 1] = a1 * rstd * g1; orow[128 + 2 * lane] = b0 * rstd * g2; orow[128 + 2 * lane + 1] = b1 * rstd * g3; }
    }
}

namespace rg {
typedef unsigned u32x4 __attribute__((ext_vector_type(4)));
constexpr int SEGT = 128, NSEG = SEQ / SEGT, XR_COL = 1536, GR_COL = 2048, YR_COL = 512, YP = 1024;
constexpr int XBP = 72  , XUP = 68  ;
constexpr int XB_OFF = 0, XU_OFF = 16 * XBP * 2, AA_OFF = XU_OFF + 16 * XUP * 4, XR_OFF = AA_OFF + 16 * XUP * 4, XRP = 72  , WAVE_LDS = XR_OFF + 24 * XRP * 2;
static_assert(WAVE_LDS * NWAVES <= RING_BYTES, "rg LDS");
#define RG_FENCE() asm volatile("s_waitcnt lgkmcnt(0)" ::: "memory")
__device__ __forceinline__ float sigm(float x) { return __builtin_amdgcn_rcpf(1.0f + __expf(-x)); }
__device__ __forceinline__ unsigned cvtpk(float lo, float hi) { unsigned r; asm volatile("v_cvt_pk_bf16_f32 %0, %1, %2" : "=v"(r) : "v"(lo), "v"(hi)); return r; }
template <bool PASS_B>
__device__ __forceinline__ void task(LAS unsigned char* wl, int lane, int b, int n, int seg, const bf16* Z, bf16* Y, float* SUM,
                                     const float* conv_w, const float* conv_b, const float* w_a, const float* b_a, const float* w_x, const float* b_x, const float* lam) {
    const int tl = lane >> 3, cgi = lane & 7, fr = lane & 15, fq = lane >> 4, chb = 64 * n;
    LAS unsigned short* XB = (LAS unsigned short*)(wl + XB_OFF); LAS float* XU = (LAS float*)(wl + XU_OFF); LAS float* AA = (LAS float*)(wl + AA_OFF);
    f32x4 cw[4][2], cbs[2];
#pragma unroll
    for (int k = 0; k < 4; ++k) { cw[k][0] = *(const f32x4*)(conv_w + k * DREC + chb + 8 * cgi); cw[k][1] = *(const f32x4*)(conv_w + k * DREC + chb + 8 * cgi + 4); }
    cbs[0] = *(const f32x4*)(conv_b + chb + 8 * cgi); cbs[1] = *(const f32x4*)(conv_b + chb + 8 * cgi + 4);
    bf16x8 wB[8][2];
#pragma unroll
    for (int gi = 0; gi < 2; ++gi) { const float* W = (gi ? w_x : w_a) + (size_t)n * 4096;
#pragma unroll
        for (int nt = 0; nt < 4; ++nt)
#pragma unroll
            for (int ks = 0; ks < 2; ++ks) { const float* p = W + (32 * ks + 8 * fq) * 64 + 16 * nt + fr;
                u32x4 w; w.x = cvtpk(p[0], p[64]); w.y = cvtpk(p[128], p[192]); w.z = cvtpk(p[256], p[320]); w.w = cvtpk(p[384], p[448]);
                wB[gi * 4 + nt][ks] = __builtin_bit_cast(bf16x8, w); } }
    float ba[4], bx[4], sp8[4];
#pragma unroll
    for (int nt = 0; nt < 4; ++nt) { const int ch = chb + 16 * nt + fr; ba[nt] = b_a[ch]; bx[nt] = b_x[ch]; const float zz = -lam[ch]; sp8[nt] = 8.0f * (fmaxf(zz, 0.f) + log1pf(expf(-fabsf(zz)))); }
    float h = 0.f, P = 1.f;
    float* S = SUM + (size_t)(b * 8 + n) * NSEG * 128;
    if (PASS_B) {
        for (int j0 = 0; j0 < seg; j0 += 8) { float Pj[8], Hj[8];
#pragma unroll
            for (int q = 0; q < 8; ++q) { const bool ok = (j0 + q) < seg; Pj[q] = ok ? S[(j0 + q) * 128 + lane] : 1.0f; Hj[q] = ok ? S[(j0 + q) * 128 + 64 + lane] : 0.0f; }
#pragma unroll
            for (int q = 0; q < 8; ++q) h = Pj[q] * h + Hj[q]; } }
    LAS unsigned short* XR = (LAS unsigned short*)(wl + XR_OFF);
    u32x4 pf[3];
#define RG_PREFETCH(sb_) do { const int t0_ = seg * SEGT + (sb_) * 16; _Pragma("unroll") for (int j_ = 0; j_ < 3; ++j_) { const int r_ = tl + 8 * j_; pf[j_] = (u32x4){0u, 0u, 0u, 0u}; \
        if (r_ < 19 && t0_ - 3 + r_ >= 0) pf[j_] = *(const u32x4*)(Z + ((size_t)b * SEQ + t0_ - 3 + r_) * ZP + XR_COL + chb + 8 * cgi); } } while (0)
    RG_PREFETCH(0);
#pragma unroll 1
    for (int sb = 0; sb < SEGT / 16; ++sb) {
        const int t0 = seg * SEGT + sb * 16; const size_t row0 = (size_t)b * SEQ + t0;
#pragma unroll
        for (int j = 0; j < 3; ++j) *(LAS u32x4*)(XR + (tl + 8 * j) * XRP + 8 * cgi) = pf[j];
        if (sb + 1 < SEGT / 16) RG_PREFETCH(sb + 1);
        u32x4 graw[2];
        if (PASS_B) {
#pragma unroll
            for (int half = 0; half < 2; ++half) graw[half] = *(const u32x4*)(Z + (row0 + 8 * half + tl) * ZP + GR_COL + chb + 8 * cgi);
        }
        RG_FENCE();
#pragma unroll
        for (int half = 0; half < 2; ++half) { const int tok = 8 * half + tl; f32x4 a0 = cbs[0], a1 = cbs[1];
#pragma unroll
            for (int k = 0; k < 4; ++k) { const u32x4 raw = *(const LAS u32x4*)(XR + (tok + k) * XRP + 8 * cgi);
                const f32x4 x0 = {__uint_as_float(raw.x << 16), __uint_as_float(raw.x & 0xffff0000u), __uint_as_float(raw.y << 16), __uint_as_float(raw.y & 0xffff0000u)};
                const f32x4 x1 = {__uint_as_float(raw.z << 16), __uint_as_float(raw.z & 0xffff0000u), __uint_as_float(raw.w << 16), __uint_as_float(raw.w & 0xffff0000u)};
                a0 += cw[k][0] * x0; a1 += cw[k][1] * x1; }
            *(LAS f32x4*)(XU + tok * XUP + 8 * cgi) = a0; *(LAS f32x4*)(XU + tok * XUP + 8 * cgi + 4) = a1;
            u32x4 pb; pb.x = cvtpk(a0[0], a0[1]); pb.y = cvtpk(a0[2], a0[3]); pb.z = cvtpk(a1[0], a1[1]); pb.w = cvtpk(a1[2], a1[3]);
            *(LAS u32x4*)(XB + tok * XBP + 8 * cgi) = pb; }
        RG_FENCE();
        const bf16x8 fa0 = *(const LAS bf16x8*)(XB + fr * XBP + 8 * fq), fa1 = *(const LAS bf16x8*)(XB + fr * XBP + 32 + 8 * fq);
        f32x4 d[8];
#pragma unroll
        for (int nt = 0; nt < 8; ++nt) { d[nt] = __builtin_amdgcn_mfma_f32_16x16x32_bf16(fa0, wB[nt][0], (f32x4){0.f, 0.f, 0.f, 0.f}, 0, 0, 0); d[nt] = __builtin_amdgcn_mfma_f32_16x16x32_bf16(fa1, wB[nt][1], d[nt], 0, 0, 0); }
#pragma unroll
        for (int nt = 0; nt < 4; ++nt)
#pragma unroll
            for (int i = 0; i < 4; ++i) { const int idx = (4 * fq + i) * XUP + 16 * nt + fr;
                const float r = sigm(d[nt][i] + ba[nt]), ig = sigm(d[4 + nt][i] + bx[nt]);
                const float la = -sp8[nt] * r, av = __expf(la), y2 = 2.0f * la;
                const float em1 = y2 * (1.0f + y2 * (0.5f + y2 * ((1.0f / 6.0f) + y2 * ((1.0f / 24.0f) + y2 * ((1.0f / 120.0f) + y2 * ((1.0f / 720.0f) + y2 * ((1.0f / 5040.0f) + y2 * (1.0f / 40320.0f))))))));
                const float xcv = XU[idx]; const float uv = __builtin_amdgcn_sqrtf(fmaxf(-em1, 0.f)) * ig * xcv;
                AA[idx] = av; XU[idx] = uv; }
        RG_FENCE();
#pragma unroll
        for (int tt = 0; tt < 16; ++tt) { const float av = AA[tt * XUP + lane], uv = XU[tt * XUP + lane]; h = av * h + uv; P *= av; if (PASS_B) XU[tt * XUP + lane] = h; }
        if (PASS_B) {
            RG_FENCE();
#pragma unroll
            for (int half = 0; half < 2; ++half) { const int tok = 8 * half + tl; const f32x4 h0 = *(const LAS f32x4*)(XU + tok * XUP + 8 * cgi), h1 = *(const LAS f32x4*)(XU + tok * XUP + 8 * cgi + 4);
                const u32x4 raw = graw[half];
                float gq[8] = {__uint_as_float(raw.x << 16), __uint_as_float(raw.x & 0xffff0000u), __uint_as_float(raw.y << 16), __uint_as_float(raw.y & 0xffff0000u),
                               __uint_as_float(raw.z << 16), __uint_as_float(raw.z & 0xffff0000u), __uint_as_float(raw.w << 16), __uint_as_float(raw.w & 0xffff0000u)};
                float yv[8];
#pragma unroll
                for (int j = 0; j < 8; ++j) { const float gg = gq[j]; const float hv = (j < 4) ? h0[j & 3] : h1[j & 3]; yv[j] = hv * gg * sigm(1.5957691216057308f * (gg + 0.044715f * gg * gg * gg)); }
                u32x4 o; o.x = cvtpk(yv[0], yv[1]); o.y = cvtpk(yv[2], yv[3]); o.z = cvtpk(yv[4], yv[5]); o.w = cvtpk(yv[6], yv[7]);
                *(u32x4*)(Y + (row0 + tok) * YP + YR_COL + chb + 8 * cgi) = o; }
        }
        RG_FENCE();
    }
    if (!PASS_B) { S[seg * 128 + lane] = P; S[seg * 128 + 64 + lane] = h; }
#undef RG_PREFETCH
}
template <bool PASS_B>
__device__ __forceinline__ void phase(LAS unsigned char* lds, int wave, int lane, int gw, int NGW, const bf16* Z, bf16* Y, float* SUM,
                                      const float* conv_w, const float* conv_b, const float* w_a, const float* b_a, const float* w_x, const float* b_x, const float* lam) {
    for (int id = gw; id < BATCH * 8 * NSEG; id += NGW) task<PASS_B>(lds + wave * WAVE_LDS, lane, id >> 8, (id >> 5) & 7, id & 31, Z, Y, SUM, conv_w, conv_b, w_a, b_a, w_x, b_x, lam);
}
__device__ __forceinline__ void phase_a_queue(LAS unsigned char* lds, int wave, int lane, unsigned* qctr, const bf16* Z, bf16* Y, float* SUM,
                                             const float* conv_w, const float* conv_b, const float* w_a, const float* b_a, const float* w_x, const float* b_x, const float* lam) {
    for (;;) { unsigned id = 0; if (lane == 0) id = __hip_atomic_fetch_add(qctr, 1u, __ATOMIC_RELAXED, __HIP_MEMORY_SCOPE_AGENT); id = (unsigned)__builtin_amdgcn_readfirstlane((int)id);
        if (id >= (unsigned)(BATCH * 8 * NSEG)) break;
        task<false>(lds + wave * WAVE_LDS, lane, (int)(id >> 8), (int)((id >> 5) & 7), (int)(id & 31), Z, Y, SUM, conv_w, conv_b, w_a, b_a, w_x, b_x, lam); }
}
}

constexpr int N_PHASES = 2 + 8 * DEPTH;
__global__ void __launch_bounds__(NWAVES * 64, 2) mk_fwd(Args args_unused) {
    extern __shared__ __attribute__((aligned(16))) unsigned char lds_raw[];
    LAS unsigned char* lds = (LAS unsigned char*)lds_raw;
    { const int t0_ = mk_tid(); if (t0_ < 32) ((LAS unsigned*)(lds + MISC_OFF))[t0_] = 0u; }
    __syncthreads();
#if !MK_MULTI
    { const __attribute__((address_space(4))) Args* apb = (const __attribute__((address_space(4))) Args*)__builtin_amdgcn_kernarg_segment_ptr();
      (void)xcd_barrier_post((unsigned*)(apb->ws + WS_CTL), (volatile LAS unsigned*)(lds + MISC_OFF) + 8); }
#endif
    typedef const __attribute__((address_space(4))) Args* kargp_t;
    int p; { kargp_t ap0 = (kargp_t)__builtin_amdgcn_kernarg_segment_ptr(); p = ap0->ph_lo; }
    for (;;) {
        kargp_t ap = (kargp_t)__builtin_amdgcn_kernarg_segment_ptr(); asm volatile("" : "+s"(ap)); asm volatile("" : "+s"(p));
        const int tid = mk_tid(), lane = tid & 63, wave = __builtin_amdgcn_readfirstlane(tid >> 6);
        int G = gridDim.x; asm volatile("" : "+s"(G));
        const int bxi = blockIdx.x, vcu = (G % 8 == 0) ? (bxi % 8) * (G / 8) + bxi / 8 : bxi;
        const int gw = vcu * NWAVES + wave, NGW = G * NWAVES;
        unsigned char* ws = ap->ws;
        float* out = ap->out;
        bf16* XN = (bf16*)(ws + WS_XN); bf16* Yb = (bf16*)(ws + WS_Y); bf16* ACT = (bf16*)(ws + WS_ACT); bf16* Zb = (bf16*)(ws + WS_ACT);
        float* LOGF = (float*)(ws + WS_LOGF); float* SUM = (float*)(ws + WS_SUM);
        bf16* XB = XN; float* SSQ = (float*)(ws + WS_SSQ); bf16* WFt = (bf16*)(ws + WS_WFT);
        if (p == 0) {
            prologue_weights(ap, lds, gw, NGW, wave, lane);
            prologue_x(ap->in[I_X], XB, SSQ, ap->in[I_WIN], ap->in[I_NG], WFt, gw, NGW, lane);
        } else if (p == N_PHASES - 1) {
            rms_final_b(XB, out, ap->in[I_FG], gw, NGW, lane);
        } else {
            const int l = (p - 1) / 8, s = (p - 1) % 8;
            if (s == 0 || s == 6) {
                const int j = (s == 6);
                pg8::Gemm g{XB, (const bf16*)(ws + WS_WFI) + (size_t)(l * 2 + j) * 2 * DFF * DM, T, 2 * DFF, DM}; pg8::StaticOrder S; S.init(T, 2 * DFF, G, bxi);
                pg8::EpiSwiGLU E{ACT, DFF, SSQ, (LAS float*)(lds + RING_BYTES + 1024), -1};
                pg8::gemm_phase<pg8::EpiSwiGLU, pg8::StaticOrder, PG8_ALIGN, PG8_SP2>(lds, g, S, E);
            } else if (s == 1 || s == 7 || s == 5) {
                const int j = (s == 7);
                const bf16* A = (s == 5) ? Yb : ACT; const int K = (s == 5) ? DM : DFF;
                const bf16* Bt = (s == 5) ? (const bf16*)(ws + WS_WO) + (size_t)l * DM * DM : (const bf16*)(ws + WS_WFO) + (size_t)(l * 2 + j) * DM * DFF;
                pg8::Gemm g{A, Bt, T, DM, K}; pg8::StaticOrder S; S.init(T, DM, G, bxi, 1);
                pg8::EpiResB E{XB, DM, (s == 5) ? 1.0f : 0.5f, SSQ};
                pg8::gemm_phase<pg8::EpiResB, pg8::StaticOrder, PG8_ALIGN, PG8_SP2>(lds, g, S, E);
            } else if (s == 2) {
                logf_phase(XB, SSQ, WFt + (size_t)l * 16 * DM, ap->in[I_BF] + l * NH, LOGF, gw, NGW, lane);
                pg8::Gemm g{XB, (const bf16*)(ws + WS_WIN) + (size_t)l * ZP * DM, T, ZP, DM}; pg8::StaticOrder S; S.init(T, ZP, G, bxi);
                pg8::EpiZ E{Zb, ZP, 2, attn_body::C2, SSQ, (LAS float*)(lds + RING_BYTES + 1024), -1};
                pg8::gemm_phase<pg8::EpiZ, pg8::StaticOrder, PG8_ALIGN, PG8_SP2>(lds, g, S, E);
            } else if (s == 3) {
                const attn_body::AttnTensors AT{(const attn_body::bf16*)Zb, (const attn_body::bf16*)(Zb + DATT), (const attn_body::bf16*)(Zb + 2 * DATT), (attn_body::bf16*)Yb};
                attn_body::attn_phase<16>((char*)lds_raw, AT, LOGF, G, vcu, (unsigned*)(ws + WS_CTL + 32768) + l * 128);
                __syncthreads();
                rg::phase_a_queue(lds, wave, lane, (unsigned*)(ws + WS_CTL + 40960) + l * 64, Zb, Yb, SUM, ap->in[I_CW] + (size_t)l * 4 * DREC, ap->in[I_CB] + l * DREC, ap->in[I_WA] + (size_t)l * 8 * 4096, ap->in[I_BA] + l * DREC,
                                  ap->in[I_WX] + (size_t)l * 8 * 4096, ap->in[I_BX] + l * DREC, ap->in[I_LAM] + l * DREC);
            } else {
                rg::phase<true>(lds, wave, lane, gw, NGW, Zb, Yb, SUM, ap->in[I_CW] + (size_t)l * 4 * DREC, ap->in[I_CB] + l * DREC, ap->in[I_WA] + (size_t)l * 8 * 4096, ap->in[I_BA] + l * DREC,
                                ap->in[I_WX] + (size_t)l * 8 * 4096, ap->in[I_BX] + l * DREC, ap->in[I_LAM] + l * DREC);
            }
        }
        ++p;
        kargp_t ap1 = (kargp_t)__builtin_amdgcn_kernarg_segment_ptr(); asm volatile("" : "+s"(ap1)); if (p >= ap1->ph_hi) break;
        if (p == 1) cg::this_grid().sync();
        else { XcdBarrier bar; bar.bar = (unsigned*)(ap1->ws + WS_CTL); bar.x = xb_xcc_id(); bar.st = (volatile LAS unsigned*)(lds + MISC_OFF) + 8; xcd_barrier(bar); }
    }
}

extern "C" void kernel_launch(void* const* d_in, const int* in_sizes, int n_in, void* d_out, int out_size, void* d_ws, size_t ws_size, hipStream_t stream) {
    static int grid = 0;
    if (grid == 0) {
        if (n_in != 15 || in_sizes[0] != T * DM || out_size != T * DM || ws_size < WS_END) { fprintf(stderr, "kernel_launch: unexpected shapes n_in %d in0 %d out %d ws %zu\n", n_in, n_in > 0 ? in_sizes[0] : -1, out_size, ws_size); grid = -1; return; }
        int dev = 0, cus = 0, per_cu = 0;
        if (hipGetDevice(&dev) != hipSuccess || hipDeviceGetAttribute(&cus, hipDeviceAttributeMultiprocessorCount, dev) != hipSuccess) { grid = -1; return; }
        if (hipFuncSetAttribute((const void*)mk_fwd, hipFuncAttributeMaxDynamicSharedMemorySize, LDS_BYTES) != hipSuccess) { fprintf(stderr, "kernel_launch: hipFuncSetAttribute failed\n"); grid = -1; return; }
        if (hipOccupancyMaxActiveBlocksPerMultiprocessor(&per_cu, (const void*)mk_fwd, NWAVES * 64, LDS_BYTES) != hipSuccess || per_cu < 1) { fprintf(stderr, "kernel_launch: occupancy query says %d\n", per_cu); per_cu = 1; }
        (void)hipGetLastError();
        grid = cus * per_cu;
    }
    if (grid < 0) return;
    Args a{};
    for (int i = 0; i < 15; ++i) a.in[i] = (const float*)d_in[i];
    a.out = (float*)d_out; a.ws = (unsigned char*)d_ws;
    if (hipMemsetAsync((char*)d_ws + WS_CTL, 0, CTL_BYTES, stream) != hipSuccess) { fprintf(stderr, "kernel_launch: memset failed\n"); return; }
#if MK_MULTI
    for (int p = 0; p < N_PHASES; ++p) { a.ph_lo = p; a.ph_hi = p + 1; hipLaunchKernelGGL(mk_fwd, dim3(grid), dim3(NWAVES * 64), LDS_BYTES, stream, a); }
#else
    a.ph_lo = 0; a.ph_hi = N_PHASES;
    void* kargs[] = {&a};
    hipError_t e = hipLaunchCooperativeKernel((const void*)mk_fwd, dim3(grid), dim3(NWAVES * 64), kargs, LDS_BYTES, stream);
    if (e != hipSuccess) fprintf(stderr, "kernel_launch: cooperative launch failed: %s (grid %d)\n", hipGetErrorString(e), grid);
#endif
}
```

```cpp
#include <hip/hip_runtime.h>
#include <hip/hip_cooperative_groups.h>
#include <cstdio>
#include <cstdint>
namespace cg = cooperative_groups;
__device__ __forceinline__ int mk_tid() { int t = (int)threadIdx.x; asm volatile("" : "+v"(t)); return t; }
#ifndef MK_MULTI
#define MK_MULTI 0
#endif
namespace pg8 {
#define PG8_LAS __attribute__((address_space(3)))
typedef unsigned short bf16_t;
typedef short bf16x8 __attribute__((ext_vector_type(8)));
typedef float f32x4 __attribute__((ext_vector_type(4)));
typedef unsigned u32x4 __attribute__((ext_vector_type(4)));
constexpr int BM = 256, BK = 64, HALF = 128, HTB = HALF * BK * 2  , STAGE_BYTES = 8 * HTB, NXCD = 8, WGM = 8;

__host__ __device__ __forceinline__ int lds_byte(int r, int c) { const int st = (r >> 4) * 2 + (c >> 5), rr = r & 15, cc = c & 31, ob = rr * 64 + cc * 2; return st * 1024 + (ob ^ (((ob >> 9) & 1) << 5)); }
__host__ __device__ __forceinline__ void stage_rc(int b, int& R, int& C) { const int st = b / 1024, sb = b % 1024, swz = sb ^ (((sb >> 9) & 1) << 5); R = (st >> 1) * 16 + swz / 64; C = (st & 1) * 32 + (swz % 64) / 2; }
__host__ __device__ __forceinline__ int perm32(int rho) { const int n = rho >> 4, i = rho & 15; return 8 * (i >> 2) + 4 * n + (i & 3); }

struct Unit { int pm, pn; };
struct Gemm { const bf16_t* A; const bf16_t* Bt; int M, N, K; };

struct StaticOrder {
    int nM, nN, nwg, G, c, rev;
    __host__ __device__ void init(int M, int N, int G_, int c_, int rev_ = 0) { nM = M / BM; nN = N / BM; nwg = nM * nN; G = G_; c = c_; rev = rev_; }
    __host__ __device__ bool next(int i, Unit& u) const {
        const int nper = (nwg + G - 1) / G; if (i >= nper) return false;
        const long L = (long)(rev ? nper - 1 - i : i) * G + c; if (L >= nwg) return false;
        int wgid = (int)L; { const int q = nwg / NXCD, r = nwg % NXCD, xcd = wgid % NXCD, off = wgid / NXCD; wgid = (xcd < r ? xcd * (q + 1) : r * (q + 1) + (xcd - r) * q) + off; }
        const int nig = WGM * nN, gid = wgid / nig, fm = gid * WGM, gsz = (nM - fm) < WGM ? (nM - fm) : WGM;
        u.pm = fm + ((wgid % nig) % gsz); u.pn = (wgid % nig) / gsz; return true;
    }
    __device__ __forceinline__ void a_ready(const Unit&) const {}
    __device__ __forceinline__ void done(const Unit&) const {}
};

__device__ __forceinline__ unsigned cvt_pk_bf16(float lo, float hi) { unsigned r; asm volatile("v_cvt_pk_bf16_f32 %0, %1, %2" : "=v"(r) : "v"(lo), "v"(hi)); return r; }
typedef float f32x2 __attribute__((ext_vector_type(2)));
__device__ __forceinline__ float silu_mul(float g, float u) { return g * u * __builtin_amdgcn_rcpf(1.0f + __expf(-g)); }
__device__ __forceinline__ float row_rstd(const float* SSQ, int row) { const f32x4* p = (const f32x4*)(SSQ + (size_t)row * 16); const f32x4 a = p[0], b = p[1], c = p[2], d = p[3]; const f32x4 s = (a + b) + (c + d);
    return __builtin_amdgcn_rsqf(((s[0] + s[1]) + (s[2] + s[3])) * (1.0f / 1024.0f) + 1e-6f); }
__device__ __forceinline__ void rstd_panel(const float* SSQ, PG8_LAS float* RS, int pm, int wr, int wc, int fr, int fq) {
    const int t = (wr * 4 + wc) * 64 + fq * 16 + fr;
    if (t < BM) RS[t] = row_rstd(SSQ, pm * BM + t);
    asm volatile("s_waitcnt lgkmcnt(0)" ::: "memory"); __builtin_amdgcn_s_barrier(); asm volatile("" ::: "memory");
}
struct EpiSwiGLU {
    static constexpr bool PERM = true, AFTER_DRAIN = false;
    bf16_t* O; int ldc; const float* SSQ; PG8_LAS float* RS; mutable int cpm;
    __device__ __forceinline__ void operator()(const f32x4 (&acc)[2][2][4][2], const Unit& u, int wr, int wc, int fr, int fq) const {
        const int row0 = u.pm * BM + wr * 64 + fr, col0 = u.pn * HALF + wc * 32 + 8 * fq;
        if (u.pm != cpm) { rstd_panel(SSQ, RS, u.pm, wr, wc, fr, fq); cpm = u.pm; }
#pragma unroll
        for (int ai = 0; ai < 2; ++ai)
#pragma unroll
            for (int m = 0; m < 4; ++m) { bf16_t* rowp = O + (size_t)(row0 + ai * HALF + m * 16) * ldc + col0;
                const float rs = RS[ai * HALF + wr * 64 + m * 16 + fr]; const float c1 = rs * -1.4426950408889634f, rs2 = rs * rs;
                f32x4 o0, o1;
                { const f32x4 g = acc[ai][0][m][0], uu = acc[ai][1][m][0]; const f32x4 t = g * c1; f32x4 e; e[0] = __builtin_amdgcn_exp2f(t[0]); e[1] = __builtin_amdgcn_exp2f(t[1]); e[2] = __builtin_amdgcn_exp2f(t[2]); e[3] = __builtin_amdgcn_exp2f(t[3]);
                  const f32x4 d = e + 1.0f; f32x4 r; r[0] = __builtin_amdgcn_rcpf(d[0]); r[1] = __builtin_amdgcn_rcpf(d[1]); r[2] = __builtin_amdgcn_rcpf(d[2]); r[3] = __builtin_amdgcn_rcpf(d[3]); o0 = ((g * uu) * rs2) * r; }
                { const f32x4 g = acc[ai][0][m][1], uu = acc[ai][1][m][1]; const f32x4 t = g * c1; f32x4 e; e[0] = __builtin_amdgcn_exp2f(t[0]); e[1] = __builtin_amdgcn_exp2f(t[1]); e[2] = __builtin_amdgcn_exp2f(t[2]); e[3] = __builtin_amdgcn_exp2f(t[3]);
                  const f32x4 d = e + 1.0f; f32x4 r; r[0] = __builtin_amdgcn_rcpf(d[0]); r[1] = __builtin_amdgcn_rcpf(d[1]); r[2] = __builtin_amdgcn_rcpf(d[2]); r[3] = __builtin_amdgcn_rcpf(d[3]); o1 = ((g * uu) * rs2) * r; }
                u32x4 w; w.x = cvt_pk_bf16(o0[0], o0[1]); w.y = cvt_pk_bf16(o0[2], o0[3]); w.z = cvt_pk_bf16(o1[0], o1[1]); w.w = cvt_pk_bf16(o1[2], o1[3]);
                *(u32x4*)rowp = w; }
    }
};
struct EpiZ {
    static constexpr bool PERM = true, AFTER_DRAIN = false;
    bf16_t* O; int ldc; int nscale; float scale0; const float* SSQ; PG8_LAS float* RS; mutable int cpm;
    __device__ __forceinline__ void operator()(const f32x4 (&acc)[2][2][4][2], const Unit& u, int wr, int wc, int fr, int fq) const {
        const int row0 = u.pm * BM + wr * 64 + fr, col0 = u.pn * BM + wc * 32 + 8 * fq; const float sc = (u.pn < nscale) ? scale0 : 1.0f;
        if (u.pm != cpm) { rstd_panel(SSQ, RS, u.pm, wr, wc, fr, fq); cpm = u.pm; }
#pragma unroll
        for (int ai = 0; ai < 2; ++ai)
#pragma unroll
            for (int m = 0; m < 4; ++m) { bf16_t* rowp = O + (size_t)(row0 + ai * HALF + m * 16) * ldc + col0; const float rs = sc * RS[ai * HALF + wr * 64 + m * 16 + fr];
#pragma unroll
                for (int bj = 0; bj < 2; ++bj) { const f32x4 v0 = acc[ai][bj][m][0] * rs, v1 = acc[ai][bj][m][1] * rs;
                    u32x4 w; w.x = cvt_pk_bf16(v0[0], v0[1]); w.y = cvt_pk_bf16(v0[2], v0[3]); w.z = cvt_pk_bf16(v1[0], v1[1]); w.w = cvt_pk_bf16(v1[2], v1[3]);
                    *(u32x4*)(rowp + bj * HALF) = w; } }
    }
};
struct EpiRes {
    static constexpr bool PERM = false, AFTER_DRAIN = false;
    const float* base; float* out; int ldc; float alpha; bf16_t* XB; float* SSQ;
    __device__ __forceinline__ void operator()(const f32x4 (&acc)[2][2][4][2], const Unit& u, int wr, int wc, int fr, int fq) const {
        typedef unsigned u32x2v __attribute__((ext_vector_type(2)));
        const int col0 = u.pn * BM + wc * 32 + 4 * fq;
#pragma unroll
        for (int ai = 0; ai < 2; ++ai) {
            f32x4 pre[4][2][2];
#pragma unroll
            for (int m = 0; m < 4; ++m) { const size_t off = (size_t)(u.pm * BM + ai * HALF + wr * 64 + m * 16 + fr) * ldc + col0;
#pragma unroll
                for (int bj = 0; bj < 2; ++bj)
#pragma unroll
                    for (int n = 0; n < 2; ++n) pre[m][bj][n] = *(const f32x4*)(base + off + bj * HALF + n * 16); }
            asm volatile("" ::: "memory");
#pragma unroll
            for (int m = 0; m < 4; ++m) { const int row = u.pm * BM + ai * HALF + wr * 64 + m * 16 + fr; const size_t off = (size_t)row * ldc + col0; float ss = 0.f;
#pragma unroll
                for (int bj = 0; bj < 2; ++bj)
#pragma unroll
                    for (int n = 0; n < 2; ++n) { const f32x4 v = pre[m][bj][n] + acc[ai][bj][m][n] * alpha; *(f32x4*)(out + off + bj * HALF + n * 16) = v;
                        ss += (v[0] * v[0] + v[1] * v[1]) + (v[2] * v[2] + v[3] * v[3]); u32x2v w; w.x = cvt_pk_bf16(v[0], v[1]); w.y = cvt_pk_bf16(v[2], v[3]); *(u32x2v*)(XB + off + bj * HALF + n * 16) = w; }
                ss += __shfl_xor(ss, 16); ss += __shfl_xor(ss, 32); if (fq == 0) SSQ[(size_t)row * 16 + u.pn * 4 + wc] = ss; }
            asm volatile("" ::: "memory");
        }
    }
};
struct EpiResB {
    static constexpr bool PERM = true, AFTER_DRAIN = false;
    bf16_t* X; int ldc; float alpha; float* SSQ;
    __device__ __forceinline__ void operator()(const f32x4 (&acc)[2][2][4][2], const Unit& u, int wr, int wc, int fr, int fq) const {
        const int col0 = u.pn * BM + wc * 32 + 8 * fq;
#pragma unroll
        for (int ai = 0; ai < 2; ++ai) {
            u32x4 pre[4][2];
#pragma unroll
            for (int m = 0; m < 4; ++m) { const size_t off = (size_t)(u.pm * BM + ai * HALF + wr * 64 + m * 16 + fr) * ldc + col0;
#pragma unroll
                for (int bj = 0; bj < 2; ++bj) pre[m][bj] = *(const u32x4*)(X + off + bj * HALF); }
            asm volatile("" ::: "memory");
#pragma unroll
            for (int m = 0; m < 4; ++m) { const int row = u.pm * BM + ai * HALF + wr * 64 + m * 16 + fr; const size_t off = (size_t)row * ldc + col0; float ss = 0.f;
#pragma unroll
                for (int bj = 0; bj < 2; ++bj) { const u32x4 b = pre[m][bj]; const f32x4 a0 = acc[ai][bj][m][0] * alpha, a1 = acc[ai][bj][m][1] * alpha; u32x4 w;
                    w.x = cvt_pk_bf16(__uint_as_float(b.x << 16) + a0[0], __uint_as_float(b.x & 0xffff0000u) + a0[1]); w.y = cvt_pk_bf16(__uint_as_float(b.y << 16) + a0[2], __uint_as_float(b.y & 0xffff0000u) + a0[3]);
                    w.z = cvt_pk_bf16(__uint_as_float(b.z << 16) + a1[0], __uint_as_float(b.z & 0xffff0000u) + a1[1]); w.w = cvt_pk_bf16(__uint_as_float(b.w << 16) + a1[2], __uint_as_float(b.w & 0xffff0000u) + a1[3]);
                    *(u32x4*)(X + off + bj * HALF) = w;
#pragma unroll
                    for (int q = 0; q < 4; ++q) { const float lo = __uint_as_float(w[q] << 16), hi = __uint_as_float(w[q] & 0xffff0000u); ss += lo * lo + hi * hi; } }
                ss += __shfl_xor(ss, 16); ss += __shfl_xor(ss, 32); if (fq == 0) SSQ[(size_t)row * 16 + u.pn * 4 + wc] = ss; }
            asm volatile("" ::: "memory");
        }
    }
};
template <class Epi, class Sched, bool ALIGN_EPI = false, bool SP2 = false>
__device__ __forceinline__ void gemm_phase(PG8_LAS unsigned char* lds, const Gemm g, const Sched& S, const Epi& E) {
    const int tid = mk_tid(), wid = __builtin_amdgcn_readfirstlane(tid >> 6), lane = tid & 63, wr = wid >> 2, wc = wid & 3, fr = lane & 15, fq = lane >> 4;
    const int K = g.K, nt = K / BK;
    unsigned voffA[2], voffB[2];
#pragma unroll
    for (int i = 0; i < 2; ++i) { int R, C; stage_rc(tid * 16 + i * 8192, R, C); const int Rb = Epi::PERM ? ((R & ~31) + perm32(R & 31)) : R;
        voffA[i] = (unsigned)(R * K + C) * 2u; voffB[i] = (unsigned)(Rb * K + C) * 2u; }
    const size_t kstep = (size_t)(BK * 2);
    const size_t hstep = (size_t)HALF * K * 2;
    const size_t tstep = 2 * hstep;
    const unsigned ldsw = (unsigned)wid * 1024u;
    const int aoff = lds_byte(wr * 64 + fr, fq * 8), boff = lds_byte(wc * 32 + fr, fq * 8);
#define PG8_SA(b, h) (((b) * 2 + (h)) * HTB)
#define PG8_SB(b, h) ((4 + (b) * 2 + (h)) * HTB)
#define PG8_STAGE(bufoff, gbase, voff) do { _Pragma("unroll") for (int _i = 0; _i < 2; ++_i) \
        __builtin_amdgcn_global_load_lds((const unsigned*)((const char*)(gbase) + (voff)[_i]), (PG8_LAS unsigned*)(lds + (bufoff) + ldsw + _i * 8192), 16, 0, 0); } while (0)
#define PG8_LDA(dst, b, h) do { _Pragma("unroll") for (int m = 0; m < 4; ++m) _Pragma("unroll") for (int k = 0; k < 2; ++k) dst[m][k] = *(const PG8_LAS bf16x8*)(lds + PG8_SA(b, h) + aoff + m * 2048 + k * 1024); } while (0)
#define PG8_LDB(dst, b, h) do { _Pragma("unroll") for (int n = 0; n < 2; ++n) _Pragma("unroll") for (int k = 0; k < 2; ++k) dst[n][k] = *(const PG8_LAS bf16x8*)(lds + PG8_SB(b, h) + boff + n * 2048 + k * 1024); } while (0)
#define PG8_MMA(ai, bj, At, Bt) do { __builtin_amdgcn_s_setprio(1); _Pragma("unroll") for (int m = 0; m < 4; ++m) _Pragma("unroll") for (int n = 0; n < 2; ++n) _Pragma("unroll") for (int k = 0; k < 2; ++k) \
        acc[ai][bj][m][n] = __builtin_amdgcn_mfma_f32_16x16x32_bf16(Bt[n][k], At[m][k], acc[ai][bj][m][n], 0, 0, 0); __builtin_amdgcn_s_setprio(0); } while (0)
#define PG8_WAIT_V(n) asm volatile("s_waitcnt vmcnt(" #n ")" ::: "memory")
#define PG8_WAIT_L(n) asm volatile("s_waitcnt lgkmcnt(" #n ")" ::: "memory")
#define PG8_BAR __builtin_amdgcn_s_barrier()
#define PG8_SCHED __builtin_amdgcn_sched_barrier(0)
    Unit cur, nxt; int ui = 0;
    if (!S.next(0, cur)) return;
    f32x4 acc[2][2][4][2];
#pragma unroll
    for (int a = 0; a < 2; ++a)
#pragma unroll
        for (int b = 0; b < 2; ++b)
#pragma unroll
            for (int m = 0; m < 4; ++m)
#pragma unroll
                for (int n = 0; n < 2; ++n) acc[a][b][m][n] = (f32x4){0.f, 0.f, 0.f, 0.f};
    bf16x8 At[4][2], B0[2][2], B1[2][2];
    const char* cA = (const char*)g.A + (size_t)cur.pm * tstep; const char* cB = (const char*)g.Bt + (size_t)cur.pn * tstep;
    S.a_ready(cur);
    if constexpr (SP2) {
        PG8_STAGE(PG8_SB(0, 0), cB, voffB); PG8_STAGE(PG8_SB(0, 1), cB + hstep, voffB); PG8_STAGE(PG8_SA(0, 0), cA, voffA); PG8_STAGE(PG8_SA(0, 1), cA + hstep, voffA);
        if (wr == 1) PG8_BAR;
        PG8_WAIT_V(2); PG8_BAR;
        PG8_STAGE(PG8_SB(1, 0), cB + kstep, voffB); PG8_STAGE(PG8_SA(1, 0), cA + kstep, voffA); PG8_STAGE(PG8_SB(1, 1), cB + hstep + kstep, voffB);
        PG8_WAIT_V(6); PG8_BAR;
    } else {
        PG8_STAGE(PG8_SB(0, 0), cB, voffB); PG8_STAGE(PG8_SA(0, 0), cA, voffA); PG8_STAGE(PG8_SB(0, 1), cB + hstep, voffB); PG8_STAGE(PG8_SA(0, 1), cA + hstep, voffA);
        if (wr == 1) PG8_BAR;
        PG8_WAIT_V(4); PG8_BAR;
        PG8_STAGE(PG8_SB(1, 0), cB + kstep, voffB); PG8_STAGE(PG8_SA(1, 0), cA + kstep, voffA); PG8_STAGE(PG8_SB(1, 1), cB + hstep + kstep, voffB);
        PG8_WAIT_V(6); PG8_BAR;
    }
    for (;;) {
        const bool has_next = S.next(ui + 1, nxt);
        const char* nA = has_next ? (const char*)g.A + (size_t)nxt.pm * tstep : cA; const char* nB = has_next ? (const char*)g.Bt + (size_t)nxt.pn * tstep : cB;
        for (int t = 0; t < nt; t += 2) {
            const bool last = (t == nt - 2);
            const char* a1 = cA + (size_t)(t + 1) * kstep;
            const char* a2 = last ? nA : cA + (size_t)(t + 2) * kstep; const char* b2 = last ? nB : cB + (size_t)(t + 2) * kstep;
            const char* a3 = a2 + kstep; const char* b3 = b2 + kstep;
            if (last && has_next) S.a_ready(nxt);
            if constexpr (SP2) {
            PG8_LDB(B0, 0, 0); PG8_LDB(B1, 0, 1); PG8_SCHED; PG8_LDA(At, 0, 0); PG8_STAGE(PG8_SA(1, 1), a1 + hstep, voffA);
            PG8_WAIT_V(8); PG8_WAIT_L(0); PG8_BAR; PG8_MMA(0, 0, At, B0); PG8_MMA(0, 1, At, B1); PG8_BAR; PG8_SCHED;
            PG8_LDA(At, 0, 1); PG8_STAGE(PG8_SB(0, 0), b2, voffB); PG8_STAGE(PG8_SB(0, 1), b2 + hstep, voffB); PG8_STAGE(PG8_SA(0, 0), a2, voffA);
            PG8_WAIT_V(8); PG8_WAIT_L(0); PG8_BAR; PG8_MMA(1, 0, At, B0); PG8_MMA(1, 1, At, B1); PG8_BAR; PG8_SCHED;
            PG8_LDB(B0, 1, 0); PG8_LDB(B1, 1, 1); PG8_SCHED; PG8_LDA(At, 1, 0); PG8_STAGE(PG8_SA(0, 1), a2 + hstep, voffA);
            PG8_WAIT_V(8); PG8_WAIT_L(0); PG8_BAR; PG8_MMA(0, 0, At, B0); PG8_MMA(0, 1, At, B1); PG8_BAR; PG8_SCHED;
            PG8_LDA(At, 1, 1); PG8_STAGE(PG8_SB(1, 0), b3, voffB); PG8_STAGE(PG8_SB(1, 1), b3 + hstep, voffB); PG8_STAGE(PG8_SA(1, 0), a3, voffA);
            PG8_WAIT_V(8); PG8_WAIT_L(0); PG8_BAR; PG8_MMA(1, 0, At, B0); PG8_MMA(1, 1, At, B1); PG8_BAR; PG8_SCHED;
            } else {
            PG8_LDB(B0, 0, 0); PG8_SCHED; PG8_LDA(At, 0, 0); PG8_STAGE(PG8_SA(1, 1), a1 + hstep, voffA);
            PG8_WAIT_L(8); PG8_BAR; PG8_WAIT_L(0); PG8_MMA(0, 0, At, B0); PG8_BAR; PG8_SCHED;
            PG8_LDB(B1, 0, 1); PG8_STAGE(PG8_SB(0, 0), b2, voffB);
            PG8_BAR; PG8_WAIT_L(0); PG8_MMA(0, 1, At, B1); PG8_BAR;
            PG8_LDA(At, 0, 1); PG8_STAGE(PG8_SA(0, 0), a2, voffA);
            PG8_BAR; PG8_WAIT_L(0); PG8_MMA(1, 0, At, B0); PG8_BAR; PG8_SCHED;
            PG8_STAGE(PG8_SB(0, 1), b2 + hstep, voffB);
            PG8_WAIT_V(6); PG8_BAR; PG8_MMA(1, 1, At, B1); PG8_BAR;
            PG8_LDB(B0, 1, 0); PG8_SCHED; PG8_LDA(At, 1, 0); PG8_STAGE(PG8_SA(0, 1), a2 + hstep, voffA);
            PG8_WAIT_L(8); PG8_BAR; PG8_WAIT_L(0); PG8_MMA(0, 0, At, B0); PG8_BAR; PG8_SCHED;
            PG8_LDB(B1, 1, 1); PG8_STAGE(PG8_SB(1, 0), b3, voffB);
            PG8_BAR; PG8_WAIT_L(0); PG8_MMA(0, 1, At, B1); PG8_BAR;
            PG8_LDA(At, 1, 1); PG8_STAGE(PG8_SA(1, 0), a3, voffA);
            PG8_BAR; PG8_WAIT_L(0); PG8_MMA(1, 0, At, B0); PG8_BAR; PG8_SCHED;
            PG8_STAGE(PG8_SB(1, 1), b3 + hstep, voffB);
            PG8_WAIT_V(6); PG8_BAR; PG8_MMA(1, 1, At, B1); PG8_BAR;
            }
        }
        if constexpr (ALIGN_EPI) { if (wr == 0) PG8_BAR; }
        if constexpr (!Epi::AFTER_DRAIN) { E(acc, cur, wr, wc, fr, fq); S.done(cur); }
        if (!has_next) break;
#pragma unroll
        for (int a = 0; a < 2; ++a)
#pragma unroll
            for (int b = 0; b < 2; ++b)
#pragma unroll
                for (int m = 0; m < 4; ++m)
#pragma unroll
                    for (int n = 0; n < 2; ++n) acc[a][b][m][n] = (f32x4){0.f, 0.f, 0.f, 0.f};
        cur = nxt; cA = nA; cB = nB; ++ui;
        if constexpr (ALIGN_EPI) { if (wr == 1) PG8_BAR; }
    }
    PG8_WAIT_V(0);
    if constexpr (!ALIGN_EPI) { if (wr == 0) PG8_BAR; }
    PG8_BAR;
    if constexpr (Epi::AFTER_DRAIN) { E.fused(acc, cur, wr, wc, fr, fq, lds, wid, lane); S.done(cur); }
#undef PG8_SA
#undef PG8_SB
#undef PG8_STAGE
#undef PG8_LDA
#undef PG8_LDB
#undef PG8_MMA
#undef PG8_WAIT_V
#undef PG8_WAIT_L
#undef PG8_BAR
#undef PG8_SCHED
}
}

#ifndef PG8_SP2
#define PG8_SP2 true
#endif
#ifndef PG8_ALIGN
#define PG8_ALIGN true
#endif
#include <hip/hip_bf16.h>
#include <cmath>
namespace attn_body {
using bf16=__hip_bfloat16;
using bf16x8=__attribute__((ext_vector_type(8)))short;
using s16x4=__attribute__((ext_vector_type(4)))short;
using f32x16=__attribute__((ext_vector_type(16)))float;
using u32x4=__attribute__((ext_vector_type(4)))unsigned;
constexpr int BATCH=8,NHEAD=8,SEQ=4096,D=64,DM=2560,OP=1024;
constexpr int NW=8,QBLK=32,QB=QBLK*NW,KVBLK=64,NQB=SEQ/QB;
constexpr int ATTN_PITCH=DM, ATTN_UNIT_ROWS=QB;
__device__ __forceinline__ int crow(int r,int hi){return (r&3)+8*(r>>2)+4*hi;}
#define SBAR() __builtin_amdgcn_sched_barrier(0)
__device__ __forceinline__ void cmask(f32x16&p0,f32x16&p1,int jb,int qrel,int hi){
  const float NEG=-INFINITY; int kb=64*jb+4*hi;
  #pragma unroll
  for(int r=0;r<16;++r){int kv=kb+(r&3)+8*(r>>2); if(kv>qrel)p0[r]=NEG; if(kv+32>qrel)p1[r]=NEG;}
}

constexpr int NSLOT=3, SLOTB=8192;
constexpr int LDS_K=0, LDS_V=NSLOT*SLOTB, LDS_WS=2*NSLOT*SLOTB, LDS_OST=LDS_WS+NW*64*4, LDS_BYTES=LDS_OST+NW*4096, LDS_EXT=86016  , LDS_EXTZ=LDS_EXT+32768  , LDS_CBW=LDS_EXTZ+512;
constexpr float C2=0.125f*1.4426950408889634f;
__device__ __forceinline__ void glds16(const void*gsrc,unsigned lds_dst){unsigned keep;
  asm volatile("s_mov_b32 %0, m0\n\ts_mov_b32 m0, %2\n\ts_nop 0\n\tglobal_load_lds_dwordx4 %1, off\n\ts_mov_b32 m0, %0":"=&s"(keep):"v"(gsrc),"s"(lds_dst):"memory");}
__device__ __forceinline__ float max3f(float a,float b,float c){float r;asm("v_max3_f32 %0, %1, %2, %3":"=v"(r):"v"(a),"v"(b),"v"(c));return r;}
__device__ __forceinline__ float max2f(float a,float b){float r;asm("v_max_f32_e32 %0, %1, %2":"=v"(r):"v"(a),"v"(b));return r;}
__device__ __forceinline__ float fadd_s(float a,float b){float r;asm("v_add_f32_e32 %0, %1, %2":"=v"(r):"v"(a),"v"(b));return r;}
__device__ __forceinline__ float fsub_s(float a,float b){float r;asm("v_sub_f32_e32 %0, %1, %2":"=v"(r):"v"(a),"v"(b));return r;}
typedef float f32x2_t __attribute__((ext_vector_type(2))); typedef __bf16 bf16x2_t __attribute__((ext_vector_type(2)));
__device__ __forceinline__ unsigned cvtpk_s(float lo,float hi){f32x2_t v={lo,hi};bf16x2_t b=__builtin_convertvector(v,bf16x2_t);return __builtin_bit_cast(unsigned,b);}
#define WAIT_BAR(N) asm volatile("s_waitcnt vmcnt(" #N ") lgkmcnt(0)\n\ts_barrier":::"memory")

__device__ __forceinline__ void qkt(f32x16&p0,f32x16&p1,const char*Kslot,const bf16x8*qr,const f32x16&negm,int r32,int hi){
  const char*kb=Kslot+hi*1024+r32*16;
  #pragma unroll
  for(int d0=0;d0<4;++d0){
    const bf16x8 b0=*reinterpret_cast<const bf16x8*>(kb+d0*2048);
    const bf16x8 b1=*reinterpret_cast<const bf16x8*>(kb+d0*2048+512);
    {p0=__builtin_amdgcn_mfma_f32_32x32x16_bf16(b0,qr[d0],p0,0,0,0);p1=__builtin_amdgcn_mfma_f32_32x32x16_bf16(b1,qr[d0],p1,0,0,0);}}
}
typedef __attribute__((address_space(3))) const char* lds_cptr;
typedef short v4i16_t __attribute__((ext_vector_type(4)));
__device__ __forceinline__ void kload8(bf16x8*kf,lds_cptr kp){
  kf[0]=*(const __attribute__((address_space(3))) bf16x8*)(kp);      kf[1]=*(const __attribute__((address_space(3))) bf16x8*)(kp+512);
  kf[2]=*(const __attribute__((address_space(3))) bf16x8*)(kp+2048); kf[3]=*(const __attribute__((address_space(3))) bf16x8*)(kp+2560);
  kf[4]=*(const __attribute__((address_space(3))) bf16x8*)(kp+4096); kf[5]=*(const __attribute__((address_space(3))) bf16x8*)(kp+4608);
  kf[6]=*(const __attribute__((address_space(3))) bf16x8*)(kp+6144); kf[7]=*(const __attribute__((address_space(3))) bf16x8*)(kp+6656);
}
__device__ __forceinline__ void kload2(bf16x8*kf,lds_cptr kp,int j){ kf[2*j]=*(const __attribute__((address_space(3))) bf16x8*)(kp+j*2048); kf[2*j+1]=*(const __attribute__((address_space(3))) bf16x8*)(kp+j*2048+512); }
__device__ __forceinline__ s16x4 vtr(lds_cptr p){ return __builtin_bit_cast(s16x4,__builtin_amdgcn_ds_read_tr16_b64_v4i16((__attribute__((address_space(3))) v4i16_t*)p)); }
__device__ __forceinline__ float rowmax(const f32x16&p0,const f32x16&p1){
  float a=max3f(p0[0],p0[1],p1[0]),b=max3f(p0[2],p0[3],p1[1]);a=max3f(a,p1[2],p1[3]);
  #pragma unroll
  for(int r=4;r<16;r+=4){a=max3f(a,p0[r],p0[r+1]);b=max3f(b,p0[r+2],p0[r+3]);a=max3f(a,p1[r],p1[r+1]);b=max3f(b,p1[r+2],p1[r+3]);}
  const float m=max2f(a,b);
  auto rr=__builtin_amdgcn_permlane32_swap(__float_as_uint(m),__float_as_uint(m),false,false);
  return max2f(__uint_as_float(rr[0]),__uint_as_float(rr[1]));
}
__device__ __forceinline__ void pv(f32x16*o,int vb,bf16x8 pa0,bf16x8 pa1,bf16x8 pa2,bf16x8 pa3){
  #pragma unroll
  for(int d0=0;d0<2;++d0){s16x4 lo[4],hi[4];
    #pragma unroll
    for(int ks=0;ks<4;++ks){
      asm volatile("ds_read_b64_tr_b16 %0,%1 offset:%c2":"=&v"(lo[ks]):"v"(vb),"i"(d0*4096+ks*1024):"memory");
      asm volatile("ds_read_b64_tr_b16 %0,%1 offset:%c2":"=&v"(hi[ks]):"v"(vb),"i"(d0*4096+ks*1024+512):"memory");}
    asm volatile("s_waitcnt lgkmcnt(0)":::"memory");SBAR();
    #define PK(k) (bf16x8){lo[k][0],lo[k][1],lo[k][2],lo[k][3],hi[k][0],hi[k][1],hi[k][2],hi[k][3]}
    o[d0]=__builtin_amdgcn_mfma_f32_32x32x16_bf16(pa0,PK(0),o[d0],0,0,0);
    o[d0]=__builtin_amdgcn_mfma_f32_32x32x16_bf16(pa1,PK(1),o[d0],0,0,0);
    o[d0]=__builtin_amdgcn_mfma_f32_32x32x16_bf16(pa2,PK(2),o[d0],0,0,0);
    o[d0]=__builtin_amdgcn_mfma_f32_32x32x16_bf16(pa3,PK(3),o[d0],0,0,0);
    #undef PK
  }
}

#ifndef ATTN_STORE16
#define ATTN_STORE16(p,v) (*(u32x4*)(p)=(v))
#endif
typedef float f32x4_t __attribute__((ext_vector_type(4)));
typedef __attribute__((address_space(3))) const float* lds_fptr;
typedef __attribute__((address_space(3))) const f32x4_t* lds_f4p;
template<int THRL> __device__ __forceinline__ void attn_unit(int b,int h,int qb,int t0,const bf16*Q,const bf16*__restrict__ K,const bf16*__restrict__ V,bf16*O,char*shm){
  const int tid=mk_tid(),lane=tid&63,r32=lane&31,hi=lane>>5; const int wid=__builtin_amdgcn_readfirstlane(tid>>6);
  const long rowbase=(long)b*SEQ; const int q0=qb*QB;
  const bf16*Qw=Q+(rowbase+q0+wid*QBLK)*DM+h*D;
  const bf16*Kh=K+(rowbase+(long)t0*KVBLK)*DM+h*D,*Vh=V+(rowbase+(long)t0*KVBLK)*DM+h*D;
  const unsigned lds0=(unsigned)(uintptr_t)shm;
  float*wsf=(float*)(shm+LDS_WS)+wid*64;
  const bf16*ksrc=Kh+(long)lane*DM+wid*8;
  const bf16*vsrc=Vh+(long)(16*(wid&3)+(lane>>2))*DM+(wid>>2)*32+(lane&3)*8;
  const unsigned kdst=lds0+LDS_K+wid*1024, vdst=lds0+LDS_V+wid*1024;
  #define DMA_K(t,slot) glds16(ksrc+(long)(t)*KVBLK*DM,(unsigned)__builtin_amdgcn_readfirstlane(kdst+(slot)))
  #define DMA_V(t,slot) glds16(vsrc+(long)(t)*KVBLK*DM,(unsigned)__builtin_amdgcn_readfirstlane(vdst+(slot)))
  const int vb0=(int)(lds0+LDS_V)+((lane>>4)&1)*32+(lane&3)*8+(4*hi+((lane&15)>>2))*64;
  const char*Kbase=shm+LDS_K; bf16x8 kf[8];
  const lds_cptr shm3=(lds_cptr)shm; const lds_cptr kp0=shm3+LDS_K+hi*1024+r32*16; const lds_cptr vp0=shm3+LDS_V+((lane>>4)&1)*32+(lane&3)*8+(4*hi+((lane&15)>>2))*64;
  const int NT=(q0+QB)/KVBLK-t0;
  DMA_K(0,0);DMA_V(0,0);DMA_K(1,SLOTB);
  bf16x8 qr[4];
  #pragma unroll
  for(int d0=0;d0<4;++d0)qr[d0]=*reinterpret_cast<const bf16x8*>(&Qw[(long)r32*DM+d0*16+hi*8]);
  float mhat=0.f,l_reg=0.f;f32x16 o[2];o[0]=f32x16{};o[1]=f32x16{};const f32x16 negm=f32x16{};
  const int qrel=wid*QBLK+r32;
  #define CMASK(P0,P1,t) do{int jb_=(t)-(NT-4); if(jb_>=0)cmask(P0,P1,jb_,qrel,hi);}while(0)
  typedef unsigned u32x2_t __attribute__((ext_vector_type(2)));
  const unsigned K2=hi?0u:0x3F803F80u;
  const lds_cptr ext_lane=(lds_cptr)shm+(hi?LDS_EXTZ:(LDS_EXT+r32*8+t0*512)); const int ext_stride=hi?0:512;
  u32x2_t ke_a,ke_b; u32x4 qe; qe.x=K2; qe.y=hi?0u:0x3F80u; qe.z=0u; qe.w=0u;
  #define KEXT_LOAD(t) do{ const lds_cptr p_=ext_lane+(t)*ext_stride; ke_a=*(const __attribute__((address_space(3))) u32x2_t*)p_; ke_b=*(const __attribute__((address_space(3))) u32x2_t*)(p_+256); }while(0)
  #define KEXT_MMA(C0,C1) do{ const u32x4 a_={ke_a.x,ke_a.y,K2,0u}, b_={ke_b.x,ke_b.y,K2,0u}; \
    C0=__builtin_amdgcn_mfma_f32_32x32x16_bf16(__builtin_bit_cast(bf16x8,a_),__builtin_bit_cast(bf16x8,qe),negm,0,0,0); \
    C1=__builtin_amdgcn_mfma_f32_32x32x16_bf16(__builtin_bit_cast(bf16x8,b_),__builtin_bit_cast(bf16x8,qe),negm,0,0,0); }while(0)
  #define QEXT_UPDATE() do{ const float nm_=-mhat; const unsigned hb_=__float_as_uint(nm_)&0xffff0000u; const float r1_=nm_-__uint_as_float(hb_); \
    const unsigned mb_=__float_as_uint(r1_)&0xffff0000u; const float r2_=r1_-__uint_as_float(mb_); const unsigned lb_=cvtpk_s(r2_,0.f)&0xffffu; \
    qe.y=hi?0u:(hb_|0x3F80u); qe.z=hi?0u:((lb_<<16)|(mb_>>16)); }while(0)
  bool resc=false;
  #define START(P0,P1) do{ const float rm=rowmax(P0,P1); resc=false; \
    { const float dl=rm; mhat=fadd_s(mhat,dl); \
      _Pragma("unroll") for(int r=0;r<16;++r){P0[r]=fsub_s(P0[r],dl);P1[r]=fsub_s(P1[r],dl);} \
      } \
    _Pragma("unroll") for(int r=0;r<16;++r)P0[r]=__builtin_amdgcn_exp2f(P0[r]); }while(0)
  #define RESC() do{ if(resc){ asm volatile("s_waitcnt lgkmcnt(0)":::"memory"); \
      _Pragma("unroll") for(int d_=0;d_<2;++d_) _Pragma("unroll") for(int r=0;r<16;++r)o[d_][r]*=wsf[crow(r,hi)]; } }while(0)
  f32x16 pA0,pA1,pB0,pB1;
  int sl_prev=0,sl_cur=0,sl_next=SLOTB;
  #define ROT() do{sl_prev=sl_cur;sl_cur=sl_next;sl_next=(sl_next==(NSLOT-1)*SLOTB)?0:sl_next+SLOTB;}while(0)
  DMA_K(2,2*SLOTB);
  WAIT_BAR(3);
  KEXT_LOAD(0);KEXT_MMA(pA0,pA1);qkt(pA0,pA1,Kbase,qr,negm,r32,hi);asm volatile("s_nop 15\n\ts_nop 7":"+v"(pA0),"+v"(pA1));CMASK(pA0,pA1,0);
  START(pA0,pA1); QEXT_UPDATE(); KEXT_LOAD(1);
  _Pragma("unroll") for(int r=0;r<16;++r)pA1[r]=__builtin_amdgcn_exp2f(pA1[r]);
  WAIT_BAR(0);
  DMA_K(3,0);DMA_V(1,SLOTB);
  ROT();
  kload8(kf,kp0+sl_cur);
  WAIT_BAR(2);
  s16x4 vlo[8],vhi[8]; u32x4 pw0,pw1,pw2,pw3;
  #define PKW(P,B) cvtpk_s(P[B],P[B+1])
  #define PAF(k) __builtin_bit_cast(bf16x8,pw##k)
  #define VFR(i) (bf16x8){vlo[i][0],vlo[i][1],vlo[i][2],vlo[i][3],vhi[i][0],vhi[i][1],vhi[i][2],vhi[i][3]}
  #define PIN(x) asm volatile("":"+v"(x))
  #define MX3(a,b,c) __builtin_fmaxf(__builtin_fmaxf((a),(b)),(c))
  #define GAPA(MF,A0,A1,A2,A3,W0,W1,PW) do{ MF; sacc+=A0; sacc+=A1; sacc+=A2; sacc+=A3; PIN(sacc); W0; W1; PIN(PW); SBAR(); }while(0)
  #define EX(v) __builtin_amdgcn_exp2f(v)
  #define GAPB(MF,X,B) do{ MF; X[B]=EX(X[B]); X[B+1]=EX(X[B+1]); X[B+2]=EX(X[B+2]); X[B+3]=EX(X[B+3]); PIN(X); SBAR(); }while(0)
  #define VRD(i) do{ vlo[i]=vtr(vp_+(((i)>>2)*4096+((i)&3)*1024)); vhi[i]=vtr(vp_+(((i)>>2)*4096+((i)&3)*1024+512)); }while(0)
  #define KRD(G,j) do{ if(G){ kload2(kf,kp0+sl_next,j); SBAR(); } }while(0)
  #define STEP(C0,C1,P0,P1,t,GK,GV,GL) do{ SBAR(); \
    const lds_cptr vp_=vp0+sl_prev; \
    KEXT_MMA(C0,C1); SBAR(); \
    VRD(0); SBAR(); float sacc=(P0[0]+P0[1]); \
    GAPA(C0=__builtin_amdgcn_mfma_f32_32x32x16_bf16(kf[0],qr[0],C0,0,0,0), P0[2],P0[3],P0[4],P0[5],     pw0[0]=PKW(P0,0), pw0[1]=PKW(P0,2), pw0); \
    VRD(4); SBAR(); GAPA(C1=__builtin_amdgcn_mfma_f32_32x32x16_bf16(kf[1],qr[0],C1,0,0,0), P0[6],P0[7],P0[8],P0[9],     pw0[2]=PKW(P0,4), pw0[3]=PKW(P0,6), pw0); \
    VRD(1); SBAR(); GAPA(C0=__builtin_amdgcn_mfma_f32_32x32x16_bf16(kf[2],qr[1],C0,0,0,0),   P0[10],P0[11],P0[12],P0[13], pw1[0]=PKW(P0,8), pw1[1]=PKW(P0,10), pw1); \
    VRD(5); SBAR(); GAPA(C1=__builtin_amdgcn_mfma_f32_32x32x16_bf16(kf[3],qr[1],C1,0,0,0),   P0[14],P0[15],P1[0],P1[1],   pw1[2]=PKW(P0,12),pw1[3]=PKW(P0,14), pw1); \
    VRD(2); SBAR(); GAPA(C0=__builtin_amdgcn_mfma_f32_32x32x16_bf16(kf[4],qr[2],C0,0,0,0),   P1[2],P1[3],P1[4],P1[5],     pw2[0]=PKW(P1,0), pw2[1]=PKW(P1,2), pw2); \
    VRD(6); SBAR(); GAPA(C1=__builtin_amdgcn_mfma_f32_32x32x16_bf16(kf[5],qr[2],C1,0,0,0),   P1[6],P1[7],P1[8],P1[9],     pw2[2]=PKW(P1,4), pw2[3]=PKW(P1,6), pw2); \
    VRD(3); SBAR(); GAPA(C0=__builtin_amdgcn_mfma_f32_32x32x16_bf16(kf[6],qr[3],C0,0,0,0),   P1[10],P1[11],P1[12],P1[13], pw3[0]=PKW(P1,8), pw3[1]=PKW(P1,10), pw3); \
    VRD(7); SBAR(); GAPA(C1=__builtin_amdgcn_mfma_f32_32x32x16_bf16(kf[7],qr[3],C1,0,0,0),   P1[14],P1[15],0.f,0.f,       pw3[2]=PKW(P1,12),pw3[3]=PKW(P1,14), pw3); \
    l_reg+=sacc; \
    if(GK){DMA_K((t)+3,sl_cur);} if(GV){DMA_V((t)+1,sl_next);} \
    CMASK(C0,C1,t); \
    { float a=MX3(C0[0],C0[1],C1[0]),b=MX3(C0[2],C0[3],C1[1]); a=MX3(a,C1[2],C1[3]); \
      _Pragma("unroll") for(int r=4;r<16;r+=4){a=MX3(a,C0[r],C0[r+1]);b=MX3(b,C0[r+2],C0[r+3]);a=MX3(a,C1[r],C1[r+1]);b=MX3(b,C1[r+2],C1[r+3]);} \
      float rm=__builtin_fmaxf(a,b); { auto rr=__builtin_amdgcn_permlane32_swap(__float_as_uint(rm),__float_as_uint(rm),false,false); rm=__builtin_fmaxf(__uint_as_float(rr[0]),__uint_as_float(rr[1])); } \
      resc=false; \
      if(__builtin_expect(__any(rm>(float)THRL),0)){ const float dl=__builtin_fmaxf(rm,0.f); mhat+=dl; QEXT_UPDATE(); \
        _Pragma("unroll") for(int r=0;r<16;++r){C0[r]-=dl;C1[r]-=dl;} \
        const float f=__builtin_amdgcn_exp2f(-dl); l_reg*=f; if(hi==0)wsf[r32]=f; resc=true; } } \
    SBAR(); \
    GAPB(o[0]=__builtin_amdgcn_mfma_f32_32x32x16_bf16(PAF(0),VFR(0),o[0],0,0,0), C0,0); \
    GAPB(o[1]=__builtin_amdgcn_mfma_f32_32x32x16_bf16(PAF(0),VFR(4),o[1],0,0,0), C0,4); \
    KRD(GL,0); if(GL){KEXT_LOAD((t)+1); SBAR();} GAPB(o[0]=__builtin_amdgcn_mfma_f32_32x32x16_bf16(PAF(1),VFR(1),o[0],0,0,0), C0,8); \
    KRD(GL,1); GAPB(o[1]=__builtin_amdgcn_mfma_f32_32x32x16_bf16(PAF(1),VFR(5),o[1],0,0,0), C0,12); \
    KRD(GL,2); GAPB(o[0]=__builtin_amdgcn_mfma_f32_32x32x16_bf16(PAF(2),VFR(2),o[0],0,0,0), C1,0); \
    KRD(GL,3); GAPB(o[1]=__builtin_amdgcn_mfma_f32_32x32x16_bf16(PAF(2),VFR(6),o[1],0,0,0), C1,4); \
    GAPB(o[0]=__builtin_amdgcn_mfma_f32_32x32x16_bf16(PAF(3),VFR(3),o[0],0,0,0), C1,8); \
    GAPB(o[1]=__builtin_amdgcn_mfma_f32_32x32x16_bf16(PAF(3),VFR(7),o[1],0,0,0), C1,12); \
    }while(0)
  int t=1;
  #undef CMASK
  #define CMASK(P0,P1,t) do{}while(0)
  for(;t+5<NT;t+=2){
    STEP(pB0,pB1,pA0,pA1,t,true,true,true);     WAIT_BAR(2); RESC(); ROT();
    STEP(pA0,pA1,pB0,pB1,t+1,true,true,true);   WAIT_BAR(2); RESC(); ROT();
  }
  #undef CMASK
  #define CMASK(P0,P1,t) do{int jb_=(t)-(NT-4); if(jb_>=0)cmask(P0,P1,jb_,qrel,hi);}while(0)
  #define ENDW(tt) do{ if((tt)+3<NT){WAIT_BAR(2);} else if((tt)+2<NT){WAIT_BAR(1);} else {WAIT_BAR(0);} }while(0)
  for(;t+1<NT;t+=2){
    STEP(pB0,pB1,pA0,pA1,t,(t+3<NT),(t+1<NT),(t+1<NT));       ENDW(t);   RESC(); ROT();
    STEP(pA0,pA1,pB0,pB1,t+1,(t+4<NT),(t+2<NT),(t+2<NT));     ENDW(t+1); RESC(); ROT();
  }
  STEP(pB0,pB1,pA0,pA1,NT-1,false,false,false); RESC();
  { float sacc=pB0[0]+pB0[1]; _Pragma("unroll") for(int r=2;r<16;++r)sacc+=pB0[r]; _Pragma("unroll") for(int r=0;r<16;++r)sacc+=pB1[r]; l_reg+=sacc;
    pw0=(u32x4){PKW(pB0,0),PKW(pB0,2),PKW(pB0,4),PKW(pB0,6)};pw1=(u32x4){PKW(pB0,8),PKW(pB0,10),PKW(pB0,12),PKW(pB0,14)};pw2=(u32x4){PKW(pB1,0),PKW(pB1,2),PKW(pB1,4),PKW(pB1,6)};pw3=(u32x4){PKW(pB1,8),PKW(pB1,10),PKW(pB1,12),PKW(pB1,14)};
    SBAR(); pv(o,vb0+sl_cur,PAF(0),PAF(1),PAF(2),PAF(3)); }
  #undef PKW
  #undef PAF
  #undef VFR
  #undef PIN
  #undef MX3
  #undef GAPA
  #undef GAPB
  #undef EX
  #undef VRD
  #undef KRD
  #undef STEP
  #undef ENDW
  {auto rr=__builtin_amdgcn_permlane32_swap(__float_as_uint(l_reg),__float_as_uint(l_reg),false,false);l_reg=__uint_as_float(rr[0])+__uint_as_float(rr[1]);}
  if(hi==0)wsf[32+r32]=l_reg;asm volatile("s_waitcnt lgkmcnt(0)":::"memory");
  float rli[16];
  #pragma unroll
  for(int r=0;r<16;++r)rli[r]=__builtin_amdgcn_rcpf(wsf[32+crow(r,hi)]);
  bf16*Ow=O+(rowbase+q0+wid*QBLK)*OP+h*D;
  { bf16*stg=(bf16*)(shm+LDS_OST)+wid*2048;
    #pragma unroll
    for(int r=0;r<16;++r){const int orow=crow(r,hi);
      #pragma unroll
      for(int d0=0;d0<2;++d0)stg[orow*64+d0*32+r32]=__float2bfloat16(o[d0][r]*rli[r]);}
    asm volatile("s_waitcnt lgkmcnt(0)":::"memory");
    #pragma unroll
    for(int i=0;i<4;++i){const int row=i*8+(lane>>3),ch=lane&7; const u32x4 v=*(const u32x4*)(stg+row*64+ch*8); ATTN_STORE16(Ow+(long)row*OP+ch*8,v);} }
  asm volatile("s_waitcnt lgkmcnt(0)\n\ts_barrier":::"memory");
  #undef KEXT_LOAD
  #undef KEXT_MMA
  #undef QEXT_UPDATE
  #undef DMA_K
  #undef DMA_V
  #undef CMASK
  #undef START
  #undef RESC
  #undef ROT
}
constexpr int ATTN_LDS_BYTES=LDS_BYTES;
struct AttnTensors { const bf16* Q; const bf16* K; const bf16* V; bf16* O; };
struct AttnTensors_dummy_{};
constexpr float PRUNE_THR=37.0f;
constexpr int LDS_BQ=LDS_CBW+64, LDS_T0=LDS_BQ+64, LDS_NRM=LDS_T0+64;
typedef __bf16 bf16x2_t2 __attribute__((ext_vector_type(2)));
__device__ __forceinline__ float sumsq8(const u32x4 r){ float s=0.f;
  #pragma unroll
  for(int q=0;q<4;++q){ const bf16x2_t2 p=__builtin_bit_cast(bf16x2_t2,r[q]); s=__builtin_amdgcn_fdot2_f32_bf16(p,p,s,false); } return s; }
__device__ __forceinline__ float dot8(const u32x4 a,const u32x4 b){ float s=0.f;
  #pragma unroll
  for(int q=0;q<4;++q) s=__builtin_amdgcn_fdot2_f32_bf16(__builtin_bit_cast(bf16x2_t2,a[q]),__builtin_bit_cast(bf16x2_t2,b[q]),s,false); return s; }
__device__ __forceinline__ float sum8lanes(float s){
  s+=__builtin_bit_cast(float,__builtin_amdgcn_update_dpp(0,__builtin_bit_cast(int,s),0xB1,0xF,0xF,true));
  s+=__builtin_bit_cast(float,__builtin_amdgcn_update_dpp(0,__builtin_bit_cast(int,s),0x4E,0xF,0xF,true));
  s+=__builtin_bit_cast(float,__builtin_amdgcn_update_dpp(0,__builtin_bit_cast(int,s),0x141,0xF,0xF,true)); return s; }
__device__ __forceinline__ int unit_qb(int i,int s){ return (i==0)?(15-s):(i==1)?(8+s):(i==2)?(7-s):s; }
__device__ __forceinline__ void cb_fill(char*lds,const float*logf,const bf16*Q,const bf16*K,int b,int h,int s4,unsigned*gx){
  const int tid=mk_tid(),lane=tid&63; const int wid=__builtin_amdgcn_readfirstlane(tid>>6);
  typedef unsigned u32x2_t __attribute__((ext_vector_type(2)));
  u32x2_t*ext=(u32x2_t*)(lds+LDS_EXT); float*wt=(float*)(lds+LDS_CBW); float*bq=(float*)(lds+LDS_BQ); int*t0s=(int*)(lds+LDS_T0); float*nrm=(float*)(lds+LDS_NRM);
  float v[8]; const float*src=logf+((size_t)b*SEQ+(size_t)tid*8)*NHEAD+h;
  #pragma unroll
  for(int i=0;i<8;++i)v[i]=src[i*NHEAD];
  float q2b[4]={0.f,0.f,0.f,0.f},dmn[4]={3.0e38f,3.0e38f,3.0e38f,3.0e38f},k2=0.f;
  { const bf16*qp=Q+((size_t)b*SEQ+(tid>>3))*DM+h*D+(tid&7)*8; const bf16*kp=K+((size_t)b*SEQ+(tid>>3))*DM+h*D+(tid&7)*8;
    #pragma unroll
    for(int i=0;i<4;++i){ const bf16*qq=qp+(size_t)unit_qb(i,s4)*QB*DM;
      #pragma unroll
      for(int it=0;it<4;++it){ const u32x4 qv=*(const u32x4*)(qq+(size_t)it*64*DM), kv=*(const u32x4*)(kp+((size_t)unit_qb(i,s4)*QB+(size_t)it*64)*DM);
        q2b[i]=fmaxf(q2b[i],sum8lanes(sumsq8(qv))); dmn[i]=fminf(dmn[i],sum8lanes(dot8(qv,kv))); } }
    const int k_lo=gx?s4*(SEQ/4):0, k_n=gx?(SEQ/4)/64:SEQ/64;
    #pragma unroll 8
    for(int it=0;it<k_n;++it) k2=fmaxf(k2,sum8lanes(sumsq8(*(const u32x4*)(kp+((size_t)k_lo+(size_t)it*64)*DM))));
    #pragma unroll
    for(int o=8;o<64;o<<=1){ k2=fmaxf(k2,__shfl_xor(k2,o));
      #pragma unroll
      for(int i=0;i<4;++i){q2b[i]=fmaxf(q2b[i],__shfl_xor(q2b[i],o));dmn[i]=fminf(dmn[i],__shfl_xor(dmn[i],o));} } }
  #pragma unroll
  for(int i=1;i<8;++i)v[i]+=v[i-1];
  const float tot=v[7]; float inc=tot;
  #pragma unroll
  for(int o=1;o<64;o<<=1){const float t=__shfl_up(inc,o); if(lane>=o)inc+=t;}
  if(lane==63)wt[wid]=inc;
  if(lane==0){ nrm[wid*9+8]=k2;
    #pragma unroll
    for(int i=0;i<4;++i){nrm[wid*9+i]=q2b[i];nrm[wid*9+4+i]=dmn[i];} }
  if(tid<16)t0s[tid]=0;
  __syncthreads();
  float base=inc-tot; for(int w=0;w<wid;++w)base+=wt[w];
  if(tid==0){ float m[5]={0.f,0.f,0.f,0.f,0.f},dm[4]={3.0e38f,3.0e38f,3.0e38f,3.0e38f};
    for(int w=0;w<8;++w){ m[4]=fmaxf(m[4],nrm[w*9+8]);
      #pragma unroll
      for(int i=0;i<4;++i){m[i]=fmaxf(m[i],nrm[w*9+i]);dm[i]=fminf(dm[i],nrm[w*9+4+i]);} }
    if(gx){
      (void)__hip_atomic_fetch_max(gx,__float_as_uint(m[4]),__ATOMIC_RELAXED,__HIP_MEMORY_SCOPE_AGENT);
      asm volatile("s_waitcnt vmcnt(0)":::"memory");
      (void)__hip_atomic_fetch_add(gx+1,1u,__ATOMIC_RELAXED,__HIP_MEMORY_SCOPE_AGENT);
      unsigned sp=0; while(__hip_atomic_load(gx+1,__ATOMIC_RELAXED,__HIP_MEMORY_SCOPE_AGENT)<4u){ __builtin_amdgcn_s_sleep(2); if(++sp>(1u<<22))break; }
      m[4]=(sp>(1u<<22))?3.0e38f:__uint_as_float(__hip_atomic_load(gx,__ATOMIC_RELAXED,__HIP_MEMORY_SCOPE_AGENT)); }
    #pragma unroll
    for(int i=0;i<5;++i)nrm[80+i]=m[i];
    #pragma unroll
    for(int i=0;i<4;++i)nrm[85+i]=dm[i]; }
  float cs[8];
  #pragma unroll
  for(int i=0;i<8;++i){ const float c=-(base+v[i])*1.4426950408889634f; cs[i]=c; const unsigned hb=__float_as_uint(c)&0xffff0000u; const float r1=c-__uint_as_float(hb);
    const unsigned mb=__float_as_uint(r1)&0xffff0000u; const float r2=r1-__uint_as_float(mb); const unsigned lb=cvtpk_s(r2,0.f)&0xffffu;
    u32x2_t e; e.x=mb|(hb>>16); e.y=0x3F800000u|lb; ext[tid*8+i]=e; }
  if(tid<128)((unsigned*)(lds+LDS_EXTZ))[tid]=0u;
  if((tid&31)==0)bq[tid>>5]=cs[0];
  __syncthreads();
  if((tid&7)==7){ const int t=tid>>3; const float mb_=cs[7]; const float k2m=nrm[84];
    #pragma unroll
    for(int i=0;i<4;++i){ const int qb=unit_qb(i,s4); const float limit=PRUNE_THR+1.0f+__builtin_sqrtf(fminf(nrm[80+i]*k2m,1.0e37f))*1.001f-nrm[85+i];
      if(t<4*qb && mb_<bq[qb]-limit) atomicAdd(&t0s[qb],1); } }
  __syncthreads();
}
template<int THRL=8> __device__ __forceinline__ void attn_phase(char*lds,const AttnTensors&T,const float*logf,int G,int vcu,unsigned*gxl){
  for(int v=vcu;v<256;v+=G){
    const int bh=v>>2,s=v&3,b=bh>>3,h=bh&7;
    cb_fill(lds,logf,T.Q,T.K,b,h,s,(G==256)?gxl+bh*2:nullptr);
    for(int i=0;i<4;++i){ const int qb=unit_qb(i,s);
      int t0=((const int*)(lds+LDS_T0))[qb]; t0=(t0>4*qb?4*qb:t0)&~1; t0=__builtin_amdgcn_readfirstlane(t0);
      attn_unit<THRL>(b,h,qb,t0,T.Q,T.K,T.V,T.O,lds); }
  }
}
#undef SBAR
#undef WAIT_BAR
}
#define GAS __attribute__((address_space(1)))
#define LAS __attribute__((address_space(3)))
typedef unsigned short bf16;
typedef unsigned v4u __attribute__((ext_vector_type(4)));
typedef float f32x4 __attribute__((ext_vector_type(4)));
typedef short bf16x8 __attribute__((ext_vector_type(8)));
constexpr int NWAVES = 8;
constexpr int BATCH = 8, SEQ = 4096, DM = 1024, DEPTH = 4, NH = 8, HD = 64, DATT = 512, DREC = 512, DFF = 2816, DIN = 2568;
constexpr int T = BATCH * SEQ;
constexpr int ZP = 2560;
constexpr float EPS = 1e-6f;
constexpr size_t MiB = 1u << 20;
constexpr size_t WS_WFI = 0, WS_WFO = 88 * MiB, WS_WIN = 132 * MiB, WS_WO = 152 * MiB, WS_XN = 160 * MiB, WS_Y = 224 * MiB, WS_ACT = 288 * MiB  ,
                 WS_LOGF = 464 * MiB, WS_SUM = 466 * MiB, WS_CTL = 468 * MiB, CTL_BYTES = 65536, WS_SSQ = 469 * MiB, WS_WFT = 471 * MiB, WS_END = 472 * MiB;
static_assert((size_t)DEPTH * 2 * 2 * DFF * DM * 2 == 88 * MiB && (size_t)DEPTH * 2 * DM * DFF * 2 == 44 * MiB && (size_t)DEPTH * ZP * DM * 2 == 20 * MiB, "weights map");
static_assert((size_t)T * DFF * 2 == 176 * MiB && (size_t)T * ZP * 2 <= 176 * MiB, "act map");
constexpr int RING_BYTES = 131072, MISC_OFF = RING_BYTES + 320, LDS_BYTES = 147456;

__device__ __forceinline__ unsigned f2bf(float f) { unsigned u = __builtin_bit_cast(unsigned, f); return (u + 0x7fffu + ((u >> 16) & 1u)) >> 16; }
__device__ __forceinline__ unsigned pk2(float lo, float hi) { return f2bf(lo) | (f2bf(hi) << 16); }
#define LDS_WAIT() asm volatile("s_waitcnt lgkmcnt(0)" ::: "memory")
__device__ __forceinline__ float wave_sum(float v) {
#pragma unroll
    for (int o = 1; o < 64; o <<= 1) v += __shfl_xor(v, o);
    return v;
}
#define RLX_AGENT __ATOMIC_RELAXED, __HIP_MEMORY_SCOPE_AGENT
#define XB_TMO      128
#define XB_XCNT(j)  (256  + 64 * (j))
#define XB_XSUB(j)  (1280 + 64 * (j))
#define XB_XGEN(j)  (2304 + 64 * (j))
#define XB_TOP      3328
#define XB_TOPGEN   3392
#define XCD_BAR_WORDS 3456
#define XB_SPIN_CAP (1u << 18)

__device__ __forceinline__ unsigned xb_ld(unsigned* p)              { return __hip_atomic_load(p, __ATOMIC_RELAXED, __HIP_MEMORY_SCOPE_AGENT); }
__device__ __forceinline__ unsigned xb_add(unsigned* p, unsigned v) { return __hip_atomic_fetch_add(p, v, __ATOMIC_RELAXED, __HIP_MEMORY_SCOPE_AGENT); }
__device__ __forceinline__ unsigned xb_xcc_id() { return (unsigned)__builtin_amdgcn_s_getreg((3 << 11) | 20) & 0xFu; }
#define XB_SPIN(cond, bar) do { unsigned _sp = 0; while (cond) { __builtin_amdgcn_s_sleep(1); \
    if ((++_sp & 255u) == 0u) { if (xb_ld(&(bar)[XB_TMO])) break; if (_sp > XB_SPIN_CAP) { atomicAdd(&(bar)[XB_TMO], 1u); break; } } } } while (0)

struct XcdBarrier {
    unsigned* bar; unsigned x;
    volatile LAS unsigned* st;
};

__device__ __forceinline__ XcdBarrier xcd_barrier_post(unsigned* bar, volatile LAS unsigned* st) {
    XcdBarrier b; b.bar = bar; b.x = xb_xcc_id(); b.st = st;
    if (threadIdx.x == 0) (void)xb_add(&bar[XB_XCNT(b.x)], 1u);
    return b;
}
__device__ __forceinline__ void xcd_barrier_complete(unsigned* bar, unsigned x, unsigned& nloc, unsigned& nx) {
    const unsigned G = gridDim.x * gridDim.y * gridDim.z;
    unsigned sum, cnt, mine, sp = 0u;
    for (;;) {
        sum = 0u; cnt = 0u; mine = 0u;
#pragma unroll
        for (unsigned j = 0; j < 16; ++j) { const unsigned c = xb_ld(&bar[XB_XCNT(j)]); sum += c; cnt += (c > 0u) ? 1u : 0u; mine = (j == x) ? c : mine; }
        if (sum == G) break;
        __builtin_amdgcn_s_sleep(1);
        if ((++sp & 255u) == 0u) { if (xb_ld(&bar[XB_TMO])) break; if (sp > XB_SPIN_CAP) { atomicAdd(&bar[XB_TMO], 1u); break; } }
    }
    nloc = mine > 0u ? mine : 1u; nx = cnt > 0u ? cnt : 1u;
}

__device__ __forceinline__ void xcd_barrier(const XcdBarrier& b) {
    asm volatile("s_waitcnt vmcnt(0)" ::: "memory");
    __syncthreads();
    if (threadIdx.x == 0) {
        unsigned* bar = b.bar;
        __builtin_amdgcn_s_waitcnt(0);
        unsigned nloc = b.st[0], nx = b.st[1];
        if (nloc == 0u) { xcd_barrier_complete(bar, b.x, nloc, nx); b.st[0] = nloc; b.st[1] = nx; }
        const unsigned old = xb_add(&bar[XB_XSUB(b.x)], 1u);
        const unsigned gen = old / nloc;
        if (old + 1u == (gen + 1u) * nloc) {
            __builtin_amdgcn_fence(__ATOMIC_RELEASE, "agent");
            asm volatile("s_waitcnt vmcnt(0)" ::: "memory");
            const unsigned og = xb_add(&bar[XB_TOP], 1u);
            const unsigned tg = og / nx;
            if (og + 1u == (tg + 1u) * nx) xb_add(&bar[XB_TOPGEN], 1u);
            else XB_SPIN(xb_ld(&bar[XB_TOPGEN]) == tg, bar);
            __builtin_amdgcn_fence(__ATOMIC_ACQUIRE, "agent");
            xb_add(&bar[XB_XGEN(b.x)], 1u);
            asm volatile("s_waitcnt vmcnt(0)" ::: "memory");
        } else {
            XB_SPIN(xb_ld(&bar[XB_XGEN(b.x)]) == gen, bar);
            __builtin_amdgcn_fence(__ATOMIC_ACQUIRE, "agent");
            asm volatile("s_waitcnt vmcnt(0)" ::: "memory");
        }
    }
    __syncthreads();
}

struct Args { const float* in[15]; float* out; unsigned char* ws; int ph_lo, ph_hi; };
enum { I_X = 0, I_NG, I_WIN, I_BF, I_CW, I_CB, I_WA, I_BA, I_WX, I_BX, I_LAM, I_WO, I_WFI, I_WFO, I_FG };

struct TItem { const float* src; const float* gk; bf16* dst; int ldw, K; };
__device__ __forceinline__ TItem titem(const __attribute__((address_space(4))) Args* ap_, int it) {
    unsigned char* ws = ap_->ws; TItem d;
    constexpr int N_FI = 2 * 16 * 176, N_FO = 2 * 44 * 32, N_IN = 16 * 80, N_O = 16 * 32, N_L = N_FI + N_FO + N_IN + N_O;
    const int l = it / N_L; int r = it % N_L;
    if (r < N_FI) { const int j = r / (16 * 176); r %= (16 * 176); const int kb = r / 176, nb = r % 176; const int n = 32 * nb, k0 = 64 * kb;
        const int dst = (n < DFF) ? ((n / 128) * 256 + (n % 128)) : (((n - DFF) / 128) * 256 + 128 + ((n - DFF) % 128));
        d.src = ap_->in[I_WFI] + (size_t)(l * 2 + j) * DM * 2 * DFF + (size_t)k0 * (2 * DFF) + n; d.ldw = 2 * DFF; d.K = DM; d.gk = ap_->in[I_NG] + (size_t)(l * 3 + 2 * j) * DM + k0;
        d.dst = (bf16*)(ws + WS_WFI) + (size_t)(l * 2 + j) * 2 * DFF * DM + (size_t)dst * DM + k0; return d; }
    r -= N_FI;
    if (r < N_FO) { const int j = r / (44 * 32); r %= (44 * 32); const int kb = r / 32, nb = r % 32; const int n = 32 * nb, k0 = 64 * kb;
        d.src = ap_->in[I_WFO] + (size_t)(l * 2 + j) * DFF * DM + (size_t)k0 * DM + n; d.ldw = DM; d.K = DFF; d.gk = nullptr;
        d.dst = (bf16*)(ws + WS_WFO) + (size_t)(l * 2 + j) * DM * DFF + (size_t)n * DFF + k0; return d; }
    r -= N_FO;
    if (r < N_IN) { const int kb = r / 80, nb = r % 80; const int n = 32 * nb, k0 = 64 * kb;
        d.src = ap_->in[I_WIN] + (size_t)l * DM * DIN + (size_t)k0 * DIN + ((n < 3 * DATT) ? n : n + NH); d.ldw = DIN; d.K = DM; d.gk = ap_->in[I_NG] + (size_t)(l * 3 + 1) * DM + k0;
        d.dst = (bf16*)(ws + WS_WIN) + (size_t)l * ZP * DM + (size_t)n * DM + k0; return d; }
    r -= N_IN;
    { const int kb = r / 32, nb = r % 32; const int n = 32 * nb, k0 = 64 * kb;
        d.src = ap_->in[I_WO] + (size_t)l * DM * DM + (size_t)k0 * DM + n; d.ldw = DM; d.K = DM; d.gk = nullptr;
        d.dst = (bf16*)(ws + WS_WO) + (size_t)l * DM * DM + (size_t)n * DM + k0; return d; }
}
__device__ __forceinline__ void ti_load(const TItem& d, float (&w)[32], float (&g)[32], int lane) {
#pragma unroll
    for (int i = 0; i < 32; ++i) { const int kk = 2 * i + (lane >> 5); w[i] = d.src[(size_t)kk * d.ldw + (lane & 31)]; }
    if (d.gk) {
#pragma unroll
        for (int i = 0; i < 32; ++i) g[i] = d.gk[2 * i + (lane >> 5)];
    } else {
#pragma unroll
        for (int i = 0; i < 32; ++i) g[i] = 1.0f;
    }
}
__device__ __forceinline__ void ti_finish(const TItem& d, const float (&w)[32], const float (&g)[32], LAS float* scr, int lane) {
#pragma unroll
    for (int i = 0; i < 32; ++i) { const int kk = 2 * i + (lane >> 5); scr[kk * 33 + (lane & 31)] = w[i] * g[i]; }
    LDS_WAIT();
    const int c = lane & 7;
#pragma unroll
    for (int j = 0; j < 4; ++j) { const int n = (lane >> 3) + 8 * j; const LAS float* s = scr + (8 * c) * 33 + n;
        v4u o; o.x = pk2(s[0 * 33], s[1 * 33]); o.y = pk2(s[2 * 33], s[3 * 33]); o.z = pk2(s[4 * 33], s[5 * 33]); o.w = pk2(s[6 * 33], s[7 * 33]);
        *(GAS v4u*)(d.dst + (size_t)n * d.K + 8 * c) = o; }
    LDS_WAIT();
}
__device__ __forceinline__ void prologue_weights(const __attribute__((address_space(4))) Args* ap_, LAS unsigned char* lds, int gw, int NGW, int wave, int lane) {
    LAS float* scr = (LAS float*)(lds + wave * 16384);
    constexpr int N_ALL = DEPTH * (2 * 16 * 176 + 2 * 44 * 32 + 16 * 80 + 16 * 32);
    if (gw >= N_ALL) return;
    TItem cur = titem(ap_, gw); float wa[32], ga[32];
    ti_load(cur, wa, ga, lane);
    for (int it = gw; it < N_ALL; it += NGW) {
        const int nx = it + NGW; TItem nxt = cur; float wb[32], gb[32];
        if (nx < N_ALL) { nxt = titem(ap_, nx); ti_load(nxt, wb, gb, lane); }
        ti_finish(cur, wa, ga, scr, lane);
        cur = nxt;
#pragma unroll
        for (int i = 0; i < 32; ++i) { wa[i] = wb[i]; ga[i] = gb[i]; }
    }
}
template <bool WITH_F>
__device__ __forceinline__ void rms_phase(LAS unsigned char* lds, const float* x, const float* g, bf16* XN, const float* w_in_l, const float* b_f_l, float* LOGF, int gw, int NGW, int tid, int lane) {
    LAS float* WF0 = (LAS float*)lds; LAS float* WF1 = (LAS float*)(lds + 16384);
    if (WITH_F) {
        for (int idx = tid; idx < 8192; idx += NWAVES * 64) { const int k = idx >> 3, hh = idx & 7; const int slot = ((k >> 8) * 4 + (k & 3)) * 64 + ((k & 255) >> 2);
            const float w = w_in_l[(size_t)k * DIN + 3 * DATT + hh] * g[k]; (hh < 4 ? WF0 : WF1)[slot * 4 + (hh & 3)] = w; }
        __syncthreads();
    }
    f32x4 gv[4];
#pragma unroll
    for (int j = 0; j < 4; ++j) gv[j] = ((const f32x4*)g)[lane + 64 * j];
    for (int m = gw; m < T; m += NGW) {
        const f32x4* xr = (const f32x4*)(x + (size_t)m * DM) + lane;
        f32x4 v[4]; float ss = 0.f;
#pragma unroll
        for (int j = 0; j < 4; ++j) { v[j] = xr[64 * j]; ss += (v[j].x * v[j].x + v[j].y * v[j].y) + (v[j].z * v[j].z + v[j].w * v[j].w); }
        const float rstd = rsqrtf(wave_sum(ss) * (1.0f / DM) + EPS);
        unsigned long long* o8 = (unsigned long long*)(XN + (size_t)m * DM) + lane;
#pragma unroll
        for (int j = 0; j < 4; ++j) { const f32x4 o = v[j] * rstd * gv[j]; o8[64 * j] = (unsigned long long)pk2(o.x, o.y) | ((unsigned long long)pk2(o.z, o.w) << 32); }
        if (WITH_F) {
            f32x4 f0 = {0.f, 0.f, 0.f, 0.f}, f1 = {0.f, 0.f, 0.f, 0.f};
#pragma unroll
            for (int j = 0; j < 4; ++j)
#pragma unroll
                for (int i = 0; i < 4; ++i) { const int slot = (j * 4 + i) * 64 + lane; const f32x4 w0 = ((const LAS f32x4*)WF0)[slot], w1 = ((const LAS f32x4*)WF1)[slot]; const float xv = v[j][i]; f0 += w0 * xv; f1 += w1 * xv; }
            float z = 0.f;
#pragma unroll
            for (int hh = 0; hh < 8; ++hh) { const float s = wave_sum(hh < 4 ? f0[hh & 3] : f1[hh & 3]); if (lane == hh) z = s; }
            if (lane < 8) { z = z * rstd + b_f_l[lane]; const float nz = -z; const float sp = fmaxf(nz, 0.f) + log1pf(__expf(-fabsf(z))); LOGF[(size_t)m * NH + lane] = -sp; }
        }
    }
}
__device__ __forceinline__ void prologue_x(const float* x, bf16* XB, float* SSQ, const float* w_in, const float* ng, bf16* WFt, int gw, int NGW, int lane) {
    for (int m0 = 2 * gw; m0 < T; m0 += 2 * NGW) {
        f32x4 v[2][4]; float ss[2] = {0.f, 0.f};
#pragma unroll
        for (int q = 0; q < 2; ++q) { const f32x4* xr = (const f32x4*)(x + (size_t)(m0 + q) * DM) + lane;
#pragma unroll
            for (int j = 0; j < 4; ++j) v[q][j] = xr[64 * j]; }
#pragma unroll
        for (int q = 0; q < 2; ++q) {
#pragma unroll
            for (int j = 0; j < 4; ++j) ss[q] += (v[q][j].x * v[q][j].x + v[q][j].y * v[q][j].y) + (v[q][j].z * v[q][j].z + v[q][j].w * v[q][j].w);
            ss[q] = wave_sum(ss[q]);
            unsigned long long* o8 = (unsigned long long*)(XB + (size_t)(m0 + q) * DM) + lane;
#pragma unroll
            for (int j = 0; j < 4; ++j) o8[64 * j] = (unsigned long long)pk2(v[q][j].x, v[q][j].y) | ((unsigned long long)pk2(v[q][j].z, v[q][j].w) << 32);
            if (lane < 16) SSQ[(size_t)(m0 + q) * 16 + lane] = (lane == 0) ? ss[q] : 0.f; }
    }
    for (int idx = gw * 64 + lane; idx < DEPTH * 16 * DM; idx += NGW * 64) { const int l = idx / (16 * DM), r = idx % (16 * DM), hh = r / DM, k = r % DM;
        const float w = (hh < NH) ? w_in[(size_t)l * DM * DIN + (size_t)k * DIN + 3 * DATT + hh] * ng[(size_t)(l * 3 + 1) * DM + k] : 0.f; WFt[idx] = (bf16)f2bf(w); }
}
__device__ __forceinline__ void logf_phase(const bf16* XB, const float* SSQ, const bf16* WFt_l, const float* b_f_l, float* LOGF, int gw, int NGW, int lane) {
    const int fr = lane & 15, fq = lane >> 4;
    for (int rt = gw; rt < T / 16; rt += NGW) {
        const bf16* a = XB + (size_t)(rt * 16 + fr) * DM + 8 * fq; const bf16* b = WFt_l + (size_t)fr * DM + 8 * fq;
        f32x4 d = {0.f, 0.f, 0.f, 0.f};
#pragma unroll 16
        for (int ks = 0; ks < DM / 32; ++ks) { const bf16x8 av = *(const bf16x8*)(a + 32 * ks), bv = *(const bf16x8*)(b + 32 * ks); d = __builtin_amdgcn_mfma_f32_16x16x32_bf16(av, bv, d, 0, 0, 0); }
        if (fr < NH) { const float bias = b_f_l[fr];
#pragma unroll
            for (int i = 0; i < 4; ++i) { const int row = rt * 16 + 4 * fq + i; const float z = d[i] * pg8::row_rstd(SSQ, row) + bias; LOGF[(size_t)row * NH + fr] = -(fmaxf(-z, 0.f) + log1pf(__expf(-fabsf(z)))); } }
    }
}
__device__ __forceinline__ void rms_final(float* x, const float* g, int gw, int NGW, int lane) {
    f32x4 gv[4];
#pragma unroll
    for (int j = 0; j < 4; ++j) gv[j] = ((const f32x4*)g)[lane + 64 * j];
    for (int m = gw; m < T; m += NGW) {
        f32x4* xr = (f32x4*)(x + (size_t)m * DM) + lane;
        f32x4 v[4]; float ss = 0.f;
#pragma unroll
        for (int j = 0; j < 4; ++j) { v[j] = xr[64 * j]; ss += (v[j].x * v[j].x + v[j].y * v[j].y) + (v[j].z * v[j].z + v[j].w * v[j].w); }
        const float rstd = rsqrtf(wave_sum(ss) * (1.0f / DM) + EPS);
#pragma unroll
        for (int j = 0; j < 4; ++j) xr[64 * j] = v[j] * rstd * gv[j];
    }
}

__device__ __forceinline__ void rms_final_b(const bf16* X, float* o, const float* g, int gw, int NGW, int lane) {
    const f32x4 g0 = ((const f32x4*)g)[2 * lane], g1 = ((const f32x4*)g)[2 * lane + 1], g2 = ((const f32x4*)g)[128 + 2 * lane], g3 = ((const f32x4*)g)[128 + 2 * lane + 1];
    for (int m0 = 4 * gw; m0 < T; m0 += 4 * NGW) {
        v4u r0[4], r1[4];
#pragma unroll
        for (int q = 0; q < 4; ++q) { const v4u* xr = (const v4u*)(X + (size_t)(m0 + q) * DM) + lane; r0[q] = xr[0]; r1[q] = xr[64]; }
#pragma unroll
        for (int q = 0; q < 4; ++q) {
            const f32x4 a0 = {__uint_as_float(r0[q].x << 16), __uint_as_float(r0[q].x & 0xffff0000u), __uint_as_float(r0[q].y << 16), __uint_as_float(r0[q].y & 0xffff0000u)};
            const f32x4 a1 = {__uint_as_float(r0[q].z << 16), __uint_as_float(r0[q].z & 0xffff0000u), __uint_as_float(r0[q].w << 16), __uint_as_float(r0[q].w & 0xffff0000u)};
            const f32x4 b0 = {__uint_as_float(r1[q].x << 16), __uint_as_float(r1[q].x & 0xffff0000u), __uint_as_float(r1[q].y << 16), __uint_as_float(r1[q].y & 0xffff0000u)};
            const f32x4 b1 = {__uint_as_float(r1[q].z << 16), __uint_as_float(r1[q].z & 0xffff0000u), __uint_as_float(r1[q].w << 16), __uint_as_float(r1[q].w & 0xffff0000u)};
            const f32x4 sq = (a0 * a0 + a1 * a1) + (b0 * b0 + b1 * b1);
            const float rstd = rsqrtf(wave_sum((sq[0] + sq[1]) + (sq[2] + sq[3])) * (1.0f / DM) + EPS);
            f32x4* orow = (f32x4*)(o + (size_t)(m0 + q) * DM);
            orow[2 * lane] = a0 * rstd * g0; orow[2 * lane + 1] = a1 * rstd * g1; orow[128 + 2 * lane] = b0 * rstd * g2; orow[128 + 2 * lane + 1] = b1 * rstd * g3; }
    }
}

namespace rg {
typedef unsigned u32x4 __attribute__((ext_vector_type(4)));
constexpr int SEGT = 128, NSEG = SEQ / SEGT, XR_COL = 1536, GR_COL = 2048, YR_COL = 512, YP = 1024;
constexpr int XBP = 72  , XUP = 68  ;
constexpr int XB_OFF = 0, XU_OFF = 16 * XBP * 2, AA_OFF = XU_OFF + 16 * XUP * 4, XR_OFF = AA_OFF + 16 * XUP * 4, XRP = 72  , WAVE_LDS = XR_OFF + 24 * XRP * 2;
static_assert(WAVE_LDS * NWAVES <= RING_BYTES, "rg LDS");
#define RG_FENCE() asm volatile("s_waitcnt lgkmcnt(0)" ::: "memory")
__device__ __forceinline__ float sigm(float x) { return __builtin_amdgcn_rcpf(1.0f + __expf(-x)); }
__device__ __forceinline__ unsigned cvtpk(float lo, float hi) { unsigned r; asm volatile("v_cvt_pk_bf16_f32 %0, %1, %2" : "=v"(r) : "v"(lo), "v"(hi)); return r; }
template <bool PASS_B>
__device__ __forceinline__ void task(LAS unsigned char* wl, int lane, int b, int n, int seg, const bf16* Z, bf16* Y, float* SUM,
                                     const float* conv_w, const float* conv_b, const float* w_a, const float* b_a, const float* w_x, const float* b_x, const float* lam) {
    const int tl = lane >> 3, cgi = lane & 7, fr = lane & 15, fq = lane >> 4, chb = 64 * n;
    LAS unsigned short* XB = (LAS unsigned short*)(wl + XB_OFF); LAS float* XU = (LAS float*)(wl + XU_OFF); LAS float* AA = (LAS float*)(wl + AA_OFF);
    f32x4 cw[4][2], cbs[2];
#pragma unroll
    for (int k = 0; k < 4; ++k) { cw[k][0] = *(const f32x4*)(conv_w + k * DREC + chb + 8 * cgi); cw[k][1] = *(const f32x4*)(conv_w + k * DREC + chb + 8 * cgi + 4); }
    cbs[0] = *(const f32x4*)(conv_b + chb + 8 * cgi); cbs[1] = *(const f32x4*)(conv_b + chb + 8 * cgi + 4);
    bf16x8 wB[8][2];
#pragma unroll
    for (int gi = 0; gi < 2; ++gi) { const float* W = (gi ? w_x : w_a) + (size_t)n * 4096;
#pragma unroll
        for (int nt = 0; nt < 4; ++nt)
#pragma unroll
            for (int ks = 0; ks < 2; ++ks) { const float* p = W + (32 * ks + 8 * fq) * 64 + 16 * nt + fr;
                u32x4 w; w.x = cvtpk(p[0], p[64]); w.y = cvtpk(p[128], p[192]); w.z = cvtpk(p[256], p[320]); w.w = cvtpk(p[384], p[448]);
                wB[gi * 4 + nt][ks] = __builtin_bit_cast(bf16x8, w); } }
    float ba[4], bx[4], sp8[4];
#pragma unroll
    for (int nt = 0; nt < 4; ++nt) { const int ch = chb + 16 * nt + fr; ba[nt] = b_a[ch]; bx[nt] = b_x[ch]; const float zz = -lam[ch]; sp8[nt] = 8.0f * (fmaxf(zz, 0.f) + log1pf(expf(-fabsf(zz)))); }
    float h = 0.f, P = 1.f;
    float* S = SUM + (size_t)(b * 8 + n) * NSEG * 128;
    if (PASS_B) {
        for (int j0 = 0; j0 < seg; j0 += 8) { float Pj[8], Hj[8];
#pragma unroll
            for (int q = 0; q < 8; ++q) { const bool ok = (j0 + q) < seg; Pj[q] = ok ? S[(j0 + q) * 128 + lane] : 1.0f; Hj[q] = ok ? S[(j0 + q) * 128 + 64 + lane] : 0.0f; }
#pragma unroll
            for (int q = 0; q < 8; ++q) h = Pj[q] * h + Hj[q]; } }
    LAS unsigned short* XR = (LAS unsigned short*)(wl + XR_OFF);
    u32x4 pf[3];
#define RG_PREFETCH(sb_) do { const int t0_ = seg * SEGT + (sb_) * 16; _Pragma("unroll") for (int j_ = 0; j_ < 3; ++j_) { const int r_ = tl + 8 * j_; pf[j_] = (u32x4){0u, 0u, 0u, 0u}; \
        if (r_ < 19 && t0_ - 3 + r_ >= 0) pf[j_] = *(const u32x4*)(Z + ((size_t)b * SEQ + t0_ - 3 + r_) * ZP + XR_COL + chb + 8 * cgi); } } while (0)
    RG_PREFETCH(0);
#pragma unroll 1
    for (int sb = 0; sb < SEGT / 16; ++sb) {
        const int t0 = seg * SEGT + sb * 16; const size_t row0 = (size_t)b * SEQ + t0;
#pragma unroll
        for (int j = 0; j < 3; ++j) *(LAS u32x4*)(XR + (tl + 8 * j) * XRP + 8 * cgi) = pf[j];
        if (sb + 1 < SEGT / 16) RG_PREFETCH(sb + 1);
        u32x4 graw[2];
        if (PASS_B) {
#pragma unroll
            for (int half = 0; half < 2; ++half) graw[half] = *(const u32x4*)(Z + (row0 + 8 * half + tl) * ZP + GR_COL + chb + 8 * cgi);
        }
        RG_FENCE();
#pragma unroll
        for (int half = 0; half < 2; ++half) { const int tok = 8 * half + tl; f32x4 a0 = cbs[0], a1 = cbs[1];
#pragma unroll
            for (int k = 0; k < 4; ++k) { const u32x4 raw = *(const LAS u32x4*)(XR + (tok + k) * XRP + 8 * cgi);
                const f32x4 x0 = {__uint_as_float(raw.x << 16), __uint_as_float(raw.x & 0xffff0000u), __uint_as_float(raw.y << 16), __uint_as_float(raw.y & 0xffff0000u)};
                const f32x4 x1 = {__uint_as_float(raw.z << 16), __uint_as_float(raw.z & 0xffff0000u), __uint_as_float(raw.w << 16), __uint_as_float(raw.w & 0xffff0000u)};
                a0 += cw[k][0] * x0; a1 += cw[k][1] * x1; }
            *(LAS f32x4*)(XU + tok * XUP + 8 * cgi) = a0; *(LAS f32x4*)(XU + tok * XUP + 8 * cgi + 4) = a1;
            u32x4 pb; pb.x = cvtpk(a0[0], a0[1]); pb.y = cvtpk(a0[2], a0[3]); pb.z = cvtpk(a1[0], a1[1]); pb.w = cvtpk(a1[2], a1[3]);
            *(LAS u32x4*)(XB + tok * XBP + 8 * cgi) = pb; }
        RG_FENCE();
        const bf16x8 fa0 = *(const LAS bf16x8*)(XB + fr * XBP + 8 * fq), fa1 = *(const LAS bf16x8*)(XB + fr * XBP + 32 + 8 * fq);
        f32x4 d[8];
#pragma unroll
        for (int nt = 0; nt < 8; ++nt) { d[nt] = __builtin_amdgcn_mfma_f32_16x16x32_bf16(fa0, wB[nt][0], (f32x4){0.f, 0.f, 0.f, 0.f}, 0, 0, 0); d[nt] = __builtin_amdgcn_mfma_f32_16x16x32_bf16(fa1, wB[nt][1], d[nt], 0, 0, 0); }
#pragma unroll
        for (int nt = 0; nt < 4; ++nt)
#pragma unroll
            for (int i = 0; i < 4; ++i) { const int idx = (4 * fq + i) * XUP + 16 * nt + fr;
                const float r = sigm(d[nt][i] + ba[nt]), ig = sigm(d[4 + nt][i] + bx[nt]);
                const float la = -sp8[nt] * r, av = __expf(la), y2 = 2.0f * la;
                const float em1 = y2 * (1.0f + y2 * (0.5f + y2 * ((1.0f / 6.0f) + y2 * ((1.0f / 24.0f) + y2 * ((1.0f / 120.0f) + y2 * ((1.0f / 720.0f) + y2 * ((1.0f / 5040.0f) + y2 * (1.0f / 40320.0f))))))));
                const float xcv = XU[idx]; const float uv = __builtin_amdgcn_sqrtf(fmaxf(-em1, 0.f)) * ig * xcv;
                AA[idx] = av; XU[idx] = uv; }
        RG_FENCE();
#pragma unroll
        for (int tt = 0; tt < 16; ++tt) { const float av = AA[tt * XUP + lane], uv = XU[tt * XUP + lane]; h = av * h + uv; P *= av; if (PASS_B) XU[tt * XUP + lane] = h; }
        if (PASS_B) {
            RG_FENCE();
#pragma unroll
            for (int half = 0; half < 2; ++half) { const int tok = 8 * half + tl; const f32x4 h0 = *(const LAS f32x4*)(XU + tok * XUP + 8 * cgi), h1 = *(const LAS f32x4*)(XU + tok * XUP + 8 * cgi + 4);
                const u32x4 raw = graw[half];
                float gq[8] = {__uint_as_float(raw.x << 16), __uint_as_float(raw.x & 0xffff0000u), __uint_as_float(raw.y << 16), __uint_as_float(raw.y & 0xffff0000u),
                               __uint_as_float(raw.z << 16), __uint_as_float(raw.z & 0xffff0000u), __uint_as_float(raw.w << 16), __uint_as_float(raw.w & 0xffff0000u)};
                float yv[8];
#pragma unroll
                for (int j = 0; j < 8; ++j) { const float gg = gq[j]; const float hv = (j < 4) ? h0[j & 3] : h1[j & 3]; yv[j] = hv * gg * sigm(1.5957691216057308f * (gg + 0.044715f * gg * gg * gg)); }
                u32x4 o; o.x = cvtpk(yv[0], yv[1]); o.y = cvtpk(yv[2], yv[3]); o.z = cvtpk(yv[4], yv[5]); o.w = cvtpk(yv[6], yv[7]);
                *(u32x4*)(Y + (row0 + tok) * YP + YR_COL + chb + 8 * cgi) = o; }
        }
        RG_FENCE();
    }
    if (!PASS_B) { S[seg * 128 + lane] = P; S[seg * 128 + 64 + lane] = h; }
#undef RG_PREFETCH
}
template <bool PASS_B>
__device__ __forceinline__ void phase(LAS unsigned char* lds, int wave, int lane, int gw, int NGW, const bf16* Z, bf16* Y, float* SUM,
                                      const float* conv_w, const float* conv_b, const float* w_a, const float* b_a, const float* w_x, const float* b_x, const float* lam) {
    for (int id = gw; id < BATCH * 8 * NSEG; id += NGW) task<PASS_B>(lds + wave * WAVE_LDS, lane, id >> 8, (id >> 5) & 7, id & 31, Z, Y, SUM, conv_w, conv_b, w_a, b_a, w_x, b_x, lam);
}
__device__ __forceinline__ void phase_a_queue(LAS unsigned char* lds, int wave, int lane, unsigned* qctr, const bf16* Z, bf16* Y, float* SUM,
                                             const float* conv_w, const float* conv_b, const float* w_a, const float* b_a, const float* w_x, const float* b_x, const float* lam) {
    for (;;) { unsigned id = 0; if (lane == 0) id = __hip_atomic_fetch_add(qctr, 1u, __ATOMIC_RELAXED, __HIP_MEMORY_SCOPE_AGENT); id = (unsigned)__builtin_amdgcn_readfirstlane((int)id);
        if (id >= (unsigned)(BATCH * 8 * NSEG)) break;
        task<false>(lds + wave * WAVE_LDS, lane, (int)(id >> 8), (int)((id >> 5) & 7), (int)(id & 31), Z, Y, SUM, conv_w, conv_b, w_a, b_a, w_x, b_x, lam); }
}
}

constexpr int N_PHASES = 2 + 8 * DEPTH;
__global__ void __launch_bounds__(NWAVES * 64, 2) mk_fwd(Args args_unused) {
    extern __shared__ __attribute__((aligned(16))) unsigned char lds_raw[];
    LAS unsigned char* lds = (LAS unsigned char*)lds_raw;
    { const int t0_ = mk_tid(); if (t0_ < 32) ((LAS unsigned*)(lds + MISC_OFF))[t0_] = 0u; }
    __syncthreads();
#if !MK_MULTI
    { const __attribute__((address_space(4))) Args* apb = (const __attribute__((address_space(4))) Args*)__builtin_amdgcn_kernarg_segment_ptr();
      (void)xcd_barrier_post((unsigned*)(apb->ws + WS_CTL), (volatile LAS unsigned*)(lds + MISC_OFF) + 8); }
#endif
    typedef const __attribute__((address_space(4))) Args* kargp_t;
    int p; { kargp_t ap0 = (kargp_t)__builtin_amdgcn_kernarg_segment_ptr(); p = ap0->ph_lo; }
    for (;;) {
        kargp_t ap = (kargp_t)__builtin_amdgcn_kernarg_segment_ptr(); asm volatile("" : "+s"(ap)); asm volatile("" : "+s"(p));
        const int tid = mk_tid(), lane = tid & 63, wave = __builtin_amdgcn_readfirstlane(tid >> 6);
        int G = gridDim.x; asm volatile("" : "+s"(G));
        const int bxi = blockIdx.x, vcu = (G % 8 == 0) ? (bxi % 8) * (G / 8) + bxi / 8 : bxi;
        const int gw = vcu * NWAVES + wave, NGW = G * NWAVES;
        unsigned char* ws = ap->ws;
        float* out = ap->out;
        bf16* XN = (bf16*)(ws + WS_XN); bf16* Yb = (bf16*)(ws + WS_Y); bf16* ACT = (bf16*)(ws + WS_ACT); bf16* Zb = (bf16*)(ws + WS_ACT);
        float* LOGF = (float*)(ws + WS_LOGF); float* SUM = (float*)(ws + WS_SUM);
        bf16* XB = XN; float* SSQ = (float*)(ws + WS_SSQ); bf16* WFt = (bf16*)(ws + WS_WFT);
        if (p == 0) {
            prologue_weights(ap, lds, gw, NGW, wave, lane);
            prologue_x(ap->in[I_X], XB, SSQ, ap->in[I_WIN], ap->in[I_NG], WFt, gw, NGW, lane);
        } else if (p == N_PHASES - 1) {
            rms_final_b(XB, out, ap->in[I_FG], gw, NGW, lane);
        } else {
            const int l = (p - 1) / 8, s = (p - 1) % 8;
            if (s == 0 || s == 6) {
                const int j = (s == 6);
                pg8::Gemm g{XB, (const bf16*)(ws + WS_WFI) + (size_t)(l * 2 + j) * 2 * DFF * DM, T, 2 * DFF, DM}; pg8::StaticOrder S; S.init(T, 2 * DFF, G, bxi);
                pg8::EpiSwiGLU E{ACT, DFF, SSQ, (LAS float*)(lds + RING_BYTES + 1024), -1};
                pg8::gemm_phase<pg8::EpiSwiGLU, pg8::StaticOrder, PG8_ALIGN, PG8_SP2>(lds, g, S, E);
            } else if (s == 1 || s == 7 || s == 5) {
                const int j = (s == 7);
                const bf16* A = (s == 5) ? Yb : ACT; const int K = (s == 5) ? DM : DFF;
                const bf16* Bt = (s == 5) ? (const bf16*)(ws + WS_WO) + (size_t)l * DM * DM : (const bf16*)(ws + WS_WFO) + (size_t)(l * 2 + j) * DM * DFF;
                pg8::Gemm g{A, Bt, T, DM, K}; pg8::StaticOrder S; S.init(T, DM, G, bxi, 1);
                pg8::EpiResB E{XB, DM, (s == 5) ? 1.0f : 0.5f, SSQ};
                pg8::gemm_phase<pg8::EpiResB, pg8::StaticOrder, PG8_ALIGN, PG8_SP2>(lds, g, S, E);
            } else if (s == 2) {
                logf_phase(XB, SSQ, WFt + (size_t)l * 16 * DM, ap->in[I_BF] + l * NH, LOGF, gw, NGW, lane);
                pg8::Gemm g{XB, (const bf16*)(ws + WS_WIN) + (size_t)l * ZP * DM, T, ZP, DM}; pg8::StaticOrder S; S.init(T, ZP, G, bxi);
                pg8::EpiZ E{Zb, ZP, 2, attn_body::C2, SSQ, (LAS float*)(lds + RING_BYTES + 1024), -1};
                pg8::gemm_phase<pg8::EpiZ, pg8::StaticOrder, PG8_ALIGN, PG8_SP2>(lds, g, S, E);
            } else if (s == 3) {
                const attn_body::AttnTensors AT{(const attn_body::bf16*)Zb, (const attn_body::bf16*)(Zb + DATT), (const attn_body::bf16*)(Zb + 2 * DATT), (attn_body::bf16*)Yb};
                attn_body::attn_phase<24>((char*)lds_raw, AT, LOGF, G, vcu, (unsigned*)(ws + WS_CTL + 32768) + l * 128);
                __syncthreads();
                rg::phase_a_queue(lds, wave, lane, (unsigned*)(ws + WS_CTL + 40960) + l * 64, Zb, Yb, SUM, ap->in[I_CW] + (size_t)l * 4 * DREC, ap->in[I_CB] + l * DREC, ap->in[I_WA] + (size_t)l * 8 * 4096, ap->in[I_BA] + l * DREC,
                                  ap->in[I_WX] + (size_t)l * 8 * 4096, ap->in[I_BX] + l * DREC, ap->in[I_LAM] + l * DREC);
            } else {
                rg::phase<true>(lds, wave, lane, gw, NGW, Zb, Yb, SUM, ap->in[I_CW] + (size_t)l * 4 * DREC, ap->in[I_CB] + l * DREC, ap->in[I_WA] + (size_t)l * 8 * 4096, ap->in[I_BA] + l * DREC,
                                ap->in[I_WX] + (size_t)l * 8 * 4096, ap->in[I_BX] + l * DREC, ap->in[I_LAM] + l * DREC);
            }
        }
        ++p;
        kargp_t ap1 = (kargp_t)__builtin_amdgcn_kernarg_segment_ptr(); asm volatile("" : "+s"(ap1)); if (p >= ap1->ph_hi) break;
        if (p == 1) cg::this_grid().sync();
        else { XcdBarrier bar; bar.bar = (unsigned*)(ap1->ws + WS_CTL); bar.x = xb_xcc_id(); bar.st = (volatile LAS unsigned*)(lds + MISC_OFF) + 8; xcd_barrier(bar); }
    }
}

extern "C" void kernel_launch(void* const* d_in, const int* in_sizes, int n_in, void* d_out, int out_size, void* d_ws, size_t ws_size, hipStream_t stream) {
    static int grid = 0;
    if (grid == 0) {
        if (n_in != 15 || in_sizes[0] != T * DM || out_size != T * DM || ws_size < WS_END) { fprintf(stderr, "kernel_launch: unexpected shapes n_in %d in0 %d out %d ws %zu\n", n_in, n_in > 0 ? in_sizes[0] : -1, out_size, ws_size); grid = -1; return; }
        int dev = 0, cus = 0, per_cu = 0;
        if (hipGetDevice(&dev) != hipSuccess || hipDeviceGetAttribute(&cus, hipDeviceAttributeMultiprocessorCount, dev) != hipSuccess) { grid = -1; return; }
        if (hipFuncSetAttribute((const void*)mk_fwd, hipFuncAttributeMaxDynamicSharedMemorySize, LDS_BYTES) != hipSuccess) { fprintf(stderr, "kernel_launch: hipFuncSetAttribute failed\n"); grid = -1; return; }
        if (hipOccupancyMaxActiveBlocksPerMultiprocessor(&per_cu, (const void*)mk_fwd, NWAVES * 64, LDS_BYTES) != hipSuccess || per_cu < 1) { fprintf(stderr, "kernel_launch: occupancy query says %d\n", per_cu); per_cu = 1; }
        (void)hipGetLastError();
        grid = cus * per_cu;
    }
    if (grid < 0) return;
    Args a{};
    for (int i = 0; i < 15; ++i) a.in[i] = (const float*)d_in[i];
    a.out = (float*)d_out; a.ws = (unsigned char*)d_ws;
    if (hipMemsetAsync((char*)d_ws + WS_CTL, 0, CTL_BYTES, stream) != hipSuccess) { fprintf(stderr, "kernel_launch: memset failed\n"); return; }
#if MK_MULTI
    for (int p = 0; p < N_PHASES; ++p) { a.ph_lo = p; a.ph_hi = p + 1; hipLaunchKernelGGL(mk_fwd, dim3(grid), dim3(NWAVES * 64), LDS_BYTES, stream, a); }
#else
    a.ph_lo = 0; a.ph_hi = N_PHASES;
    void* kargs[] = {&a};
    hipError_t e = hipLaunchCooperativeKernel((const void*)mk_fwd, dim3(grid), dim3(NWAVES * 64), kargs, LDS_BYTES, stream);
    if (e != hipSuccess) fprintf(stderr, "kernel_launch: cooperative launch failed: %s (grid %d)\n", hipGetErrorString(e), grid);
#endif
}
```
